# Optimizing an MI355X kernel written in HIP

```python
import jax, jax.numpy as jnp
from jax import lax
import numpy as np

D_MODEL = 1024
BATCH = 2
SEQ = 16384
DEPTH = 1
DEC_BATCH = 8
DEC_SEQ = 2048
PAST_LEN = 128

GRID_W = 64
MLA_HEADS = 8
Q_LORA = 256
KV_LORA = 128
QK_NOPE = 64
QK_ROPE = 32
V_DIM = 64
ROPE_THETA = 10000.0
Q_BLOCK = 128
NA_HEADS = 8
NA_DIM = 64
NA_WIN_R = 8
NA_WIN_C = 16
NA_COL_BLK = 16
NA_KEY_COLS = NA_COL_BLK + NA_WIN_C
MLA_WIDTH = MLA_HEADS * V_DIM
NA_WIDTH = NA_HEADS * NA_DIM
MIX_WIDTH = MLA_WIDTH + NA_WIDTH
IN_WIDTH = Q_LORA + KV_LORA + QK_ROPE + 3 * NA_WIDTH
D_FF = 2816
CONV_W = 3
EPS = 1e-6
NEG_INF = -1e30

kernel_name = "hybrid_mla_natten_convffn_encoder"


def rms_norm(x, g):
    xf = x.astype(jnp.float32)
    y = xf * lax.rsqrt(jnp.mean(xf * xf, axis=-1, keepdims=True) + EPS)
    return (y * g.astype(jnp.float32)).astype(x.dtype)


def rope_tables(S):
    inv = 1.0 / (ROPE_THETA ** (jnp.arange(0, QK_ROPE, 2, dtype=jnp.float32) / QK_ROPE))
    ang = jnp.arange(S, dtype=jnp.float32)[:, None] * inv[None, :]
    return jnp.cos(ang), jnp.sin(ang)


def apply_rope(x, cos, sin):
    x1, x2 = jnp.split(x.astype(jnp.float32), 2, axis=-1)
    return jnp.concatenate([x1 * cos - x2 * sin, x1 * sin + x2 * cos], axis=-1).astype(x.dtype)


def mla_attention(c_q, c_kv, k_rope, g_q_lat, w_q_up, g_kv_lat, w_kv_up):
    B, S, _ = c_q.shape
    cos, sin = rope_tables(S)
    q = (rms_norm(c_q, g_q_lat) @ w_q_up).reshape(B, S, MLA_HEADS, QK_NOPE + QK_ROPE)
    q = jnp.concatenate([q[..., :QK_NOPE], apply_rope(q[..., QK_NOPE:], cos[:, None, :], sin[:, None, :])], axis=-1)
    kv = (rms_norm(c_kv, g_kv_lat) @ w_kv_up).reshape(B, S, MLA_HEADS, QK_NOPE + V_DIM)
    k_pe = apply_rope(k_rope, cos, sin)
    k = jnp.concatenate([kv[..., :QK_NOPE], jnp.broadcast_to(k_pe[:, :, None, :], (B, S, MLA_HEADS, QK_ROPE))], axis=-1)
    v = kv[..., QK_NOPE:]
    scale = (QK_NOPE + QK_ROPE) ** -0.5
    nb = S // Q_BLOCK
    qb = q.reshape(B, nb, Q_BLOCK, MLA_HEADS, QK_NOPE + QK_ROPE).transpose(1, 0, 2, 3, 4)

    def block(qi):
        s = jnp.einsum('bqhd,bkhd->bhqk', qi, k, preferred_element_type=jnp.float32) * scale
        p = jax.nn.softmax(s, axis=-1)
        return jnp.einsum('bhqk,bkhd->bqhd', p.astype(v.dtype), v)

    o = lax.map(block, qb)
    return o.transpose(1, 0, 2, 3, 4).reshape(B, S, MLA_WIDTH)


def neighborhood_attention(q, k, v, rpb):
    B, S, _ = q.shape
    rows = S // GRID_W
    kr = min(NA_WIN_R, rows)
    ncb = GRID_W // NA_COL_BLK
    shp = (B, rows, GRID_W, NA_HEADS, NA_DIM)
    q, k, v = q.reshape(shp), k.reshape(shp), v.reshape(shp)
    r = jnp.arange(rows, dtype=jnp.int32)
    row_start = jnp.clip(r - kr // 2, 0, rows - kr)
    key_rows = row_start[:, None] + jnp.arange(kr, dtype=jnp.int32)[None, :]
    j = jnp.arange(ncb, dtype=jnp.int32)
    blk_col_start = jnp.clip(j * NA_COL_BLK - NA_WIN_C // 2, 0, GRID_W - NA_KEY_COLS)
    key_cols = blk_col_start[:, None] + jnp.arange(NA_KEY_COLS, dtype=jnp.int32)[None, :]
    kb = k[:, key_rows[:, None, :, None], key_cols[None, :, None, :]]
    vb = v[:, key_rows[:, None, :, None], key_cols[None, :, None, :]]
    qb = q.reshape(B, rows, ncb, NA_COL_BLK, NA_HEADS, NA_DIM)
    s = jnp.einsum('brjqhd,brjikhd->bhrjqik', qb, kb, preferred_element_type=jnp.float32) * (NA_DIM ** -0.5)
    qcol = j[:, None] * NA_COL_BLK + jnp.arange(NA_COL_BLK, dtype=jnp.int32)[None, :]
    qcol_start = jnp.clip(qcol - NA_WIN_C // 2, 0, GRID_W - NA_WIN_C)
    kc = key_cols[:, None, :]
    col_valid = (kc >= qcol_start[:, :, None]) & (kc < qcol_start[:, :, None] + NA_WIN_C)
    dr_idx = key_rows - r[:, None] + (NA_WIN_R - 1)
    dc_idx = jnp.clip(kc - qcol[:, :, None] + (NA_WIN_C - 1), 0, 2 * NA_WIN_C - 2)
    bias = rpb.astype(jnp.float32)[:, dr_idx[:, None, None, :, None], dc_idx[None, :, :, None, :]]
    s = jnp.where(col_valid[:, :, None, :], s + bias[None], NEG_INF)
    p = jax.nn.softmax(s.reshape(B, NA_HEADS, rows, ncb, NA_COL_BLK, kr * NA_KEY_COLS), axis=-1)
    o = jnp.einsum('bhrjqn,brjnhd->brjqhd', p.astype(vb.dtype),
                   vb.reshape(B, rows, ncb, kr * NA_KEY_COLS, NA_HEADS, NA_DIM))
    return o.reshape(B, S, NA_WIDTH)


def conv_ffn(x, w_up, conv_w, conv_b, w_down):
    S = x.shape[1]
    h = x @ w_up
    pad = CONV_W // 2
    hp = jnp.pad(h, ((0, 0), (pad, pad), (0, 0)))
    hc = conv_b
    for t in range(CONV_W):
        hc = hc + hp[:, t:t + S] * conv_w[t]
    g, u = jnp.split(hc, 2, axis=-1)
    return (jax.nn.gelu(g, approximate=True) * u) @ w_down


def encoder_layer(x, g_mix_pre, w_in, g_q_lat, w_q_up, g_kv_lat, w_kv_up, na_rpb, w_o, g_mix_post,
                  g_ffn_pre, w_ffn_up, ffn_conv_w, ffn_conv_b, w_ffn_down, g_ffn_post):
    h = rms_norm(x, g_mix_pre)
    z = h @ w_in
    o1 = Q_LORA
    o2 = o1 + KV_LORA
    o3 = o2 + QK_ROPE
    c_q, c_kv, k_rope = z[..., :o1], z[..., o1:o2], z[..., o2:o3]
    nq = z[..., o3:o3 + NA_WIDTH]
    nk = z[..., o3 + NA_WIDTH:o3 + 2 * NA_WIDTH]
    nv = z[..., o3 + 2 * NA_WIDTH:]
    a = mla_attention(c_q, c_kv, k_rope, g_q_lat, w_q_up, g_kv_lat, w_kv_up)
    n = neighborhood_attention(nq, nk, nv, na_rpb)
    mix = jnp.concatenate([a, n], axis=-1) @ w_o
    x = x + rms_norm(mix, g_mix_post)
    h = rms_norm(x, g_ffn_pre)
    x = x + rms_norm(conv_ffn(h, w_ffn_up, ffn_conv_w, ffn_conv_b, w_ffn_down), g_ffn_post)
    return x


def setup_inputs(seed: int = 0) -> dict:
    key = jax.random.key(seed)
    ks = jax.random.split(key, 20)
    f32 = jnp.float32

    def nrm(k, shape, scale):
        return jax.random.normal(k, shape, f32) * scale

    def gain(k, n):
        return 1.0 + 0.02 * jax.random.normal(k, (DEPTH, n), f32)

    return {
        "x_prompt": jax.random.normal(ks[0], (BATCH, SEQ, D_MODEL), f32),
        "x_sample": jax.random.normal(ks[1], (DEC_BATCH, DEC_SEQ, D_MODEL), f32),
        "g_mix_pre": gain(ks[2], D_MODEL),
        "w_in": nrm(ks[3], (DEPTH, D_MODEL, IN_WIDTH), D_MODEL ** -0.5),
        "g_q_lat": gain(ks[4], Q_LORA),
        "w_q_up": nrm(ks[5], (DEPTH, Q_LORA, MLA_HEADS * (QK_NOPE + QK_ROPE)), Q_LORA ** -0.5),
        "g_kv_lat": gain(ks[6], KV_LORA),
        "w_kv_up": nrm(ks[7], (DEPTH, KV_LORA, MLA_HEADS * (QK_NOPE + V_DIM)), KV_LORA ** -0.5),
        "na_rpb": nrm(ks[8], (DEPTH, NA_HEADS, 2 * NA_WIN_R - 1, 2 * NA_WIN_C - 1), 0.1),
        "w_o": nrm(ks[9], (DEPTH, MIX_WIDTH, D_MODEL), MIX_WIDTH ** -0.5),
        "g_mix_post": gain(ks[10], D_MODEL),
        "g_ffn_pre": gain(ks[11], D_MODEL),
        "w_ffn_up": nrm(ks[12], (DEPTH, D_MODEL, 2 * D_FF), D_MODEL ** -0.5),
        "ffn_conv_w": nrm(ks[13], (DEPTH, CONV_W, 2 * D_FF), CONV_W ** -0.5),
        "ffn_conv_b": nrm(ks[14], (DEPTH, 2 * D_FF), 0.01),
        "w_ffn_down": nrm(ks[15], (DEPTH, D_FF, D_MODEL), D_FF ** -0.5),
        "g_ffn_post": gain(ks[16], D_MODEL),
    }


def reference(x_prompt, x_sample, g_mix_pre, w_in, g_q_lat, w_q_up, g_kv_lat, w_kv_up, na_rpb, w_o,
              g_mix_post, g_ffn_pre, w_ffn_up, ffn_conv_w, ffn_conv_b, w_ffn_down, g_ffn_post):
    y_prompt = x_prompt
    y_sample = x_sample
    for l in range(DEPTH):
        params = (g_mix_pre[l], w_in[l], g_q_lat[l], w_q_up[l], g_kv_lat[l], w_kv_up[l], na_rpb[l], w_o[l],
                  g_mix_post[l], g_ffn_pre[l], w_ffn_up[l], ffn_conv_w[l], ffn_conv_b[l], w_ffn_down[l],
                  g_ffn_post[l])
        y_prompt = encoder_layer(y_prompt, *params)
        y_sample = encoder_layer(y_sample, *params)
    return (y_prompt, y_sample)
```

```cpp
#include <hip/hip_runtime.h>
#include <hip/hip_cooperative_groups.h>
#include <cstdio>
#include <cstdint>
namespace cg = cooperative_groups;

#define LAS __attribute__((address_space(3)))
typedef unsigned short bf16_t;
typedef short bf16x8 __attribute__((ext_vector_type(8)));
typedef short s16x4 __attribute__((ext_vector_type(4)));
typedef float f32x2 __attribute__((ext_vector_type(2)));
typedef float f32x4 __attribute__((ext_vector_type(4)));
typedef float f32x16 __attribute__((ext_vector_type(16)));
typedef unsigned u32x2 __attribute__((ext_vector_type(2)));
typedef unsigned u32x4 __attribute__((ext_vector_type(4)));
typedef __bf16 bf16x2_t __attribute__((ext_vector_type(2)));

constexpr int MP = 32768, MS = 16384, M = MP + MS;
constexpr int DM = 1024, ZW = 2048, DFF = 2816, NUP = 2 * DFF;
constexpr int SP = 16384, SS = 2048;
constexpr int QW = 768, NGT = M / 64;
constexpr float EPS = 1e-6f;
constexpr float LOG2E = 1.4426950408889634f;
constexpr float QSCALE = 0.10206207261596575f * LOG2E;
constexpr int Z_CKV = 256, Z_KR = 384, Z_NQ = 416, Z_NK = 928, Z_NV = 1440;
constexpr int ZP = 1952;
constexpr int MOP = 1056;

constexpr size_t MiB = 1u << 20;
constexpr size_t WS_WIN = 1 * MiB;
constexpr size_t WS_WQ = 5 * MiB;
constexpr size_t WS_WKV = 5 * MiB + 512 * 1024;
constexpr size_t WS_WO = 6 * MiB;
constexpr size_t WS_WUP = 8 * MiB;
constexpr size_t WS_WDN = 19 * MiB;
constexpr size_t WS_COS = 25 * MiB, WS_SIN = 26 * MiB;
constexpr size_t WS_RSQ = 27 * MiB, WS_RSKV = 27 * MiB + 256 * 1024;
constexpr size_t WS_R1 = 32 * MiB;
constexpr size_t WS_Z = 128 * MiB;
constexpr size_t WS_Q = 320 * MiB, WS_K = 392 * MiB, WS_V = 464 * MiB;
constexpr size_t WS_MO = 128 * MiB;
constexpr size_t WS_ACT = 228 * MiB;
constexpr size_t WS_END = 512 * MiB;

__device__ __forceinline__ unsigned cvtpk(float lo, float hi) { f32x2 v = {lo, hi}; bf16x2_t b = __builtin_convertvector(v, bf16x2_t); return __builtin_bit_cast(unsigned, b); }
__device__ __forceinline__ float bflo(unsigned w) { return __uint_as_float(w << 16); }
__device__ __forceinline__ float bfhi(unsigned w) { return __uint_as_float(w & 0xffff0000u); }
__device__ __forceinline__ float wave_sum(float v) {
#pragma unroll
    for (int o = 1; o < 64; o <<= 1) v += __shfl_xor(v, o);
    return v;
}
__device__ __forceinline__ int lane_id_asm() { int l; asm volatile("v_mbcnt_lo_u32_b32 %0, -1, 0\n\tv_mbcnt_hi_u32_b32 %0, -1, %0" : "=v"(l)); return l; }
__device__ __forceinline__ int seqpos(int t) { return t < MP ? (t & (SP - 1)) : (t & (SS - 1)); }

__device__ __forceinline__ float gelu_tanh(float g) {
    const float u = g + 0.044715f * g * g * g;
    return g * __builtin_amdgcn_rcpf(1.f + __builtin_amdgcn_exp2f(-2.3022081983f * u));
}
__device__ __forceinline__ float dpp_prev(float v) { return __builtin_bit_cast(float, __builtin_amdgcn_mov_dpp(__builtin_bit_cast(int, v), 0x121, 0xF, 0xF, true)); }
__device__ __forceinline__ float dpp_next(float v) { return __builtin_bit_cast(float, __builtin_amdgcn_mov_dpp(__builtin_bit_cast(int, v), 0x12F, 0xF, 0xF, true)); }

template <bool EDGE> __device__ __forceinline__ void conv_col(float x0, float x1, float x2, float x3, float top, float bot, bool f0, bool f15, int sqb, int S,
                                         float w0, float w1, float w2, float b, float& h0, float& h1, float& h2, float& h3) {
    asm volatile("" : "+v"(x0), "+v"(x1), "+v"(x2), "+v"(x3));
    const float p0 = dpp_prev(x0), p1 = dpp_prev(x1), p2 = dpp_prev(x2), p3 = dpp_prev(x3);
    const float n0 = dpp_next(x0), n1 = dpp_next(x1), n2 = dpp_next(x2), n3 = dpp_next(x3);
    float u0 = f0 ? top : p0, u1 = f0 ? p0 : p1, u2 = f0 ? p1 : p2, u3 = f0 ? p2 : p3;
    float d0 = f15 ? n1 : n0, d1 = f15 ? n2 : n1, d2 = f15 ? n3 : n2, d3 = f15 ? bot : n3;
    if (EDGE) {
    const int sm = S - 1;
    u0 = ((sqb & sm) == 0) ? 0.f : u0; u1 = (((sqb + 16) & sm) == 0) ? 0.f : u1; u2 = (((sqb + 32) & sm) == 0) ? 0.f : u2; u3 = (((sqb + 48) & sm) == 0) ? 0.f : u3;
    d0 = ((sqb & sm) == sm) ? 0.f : d0; d1 = (((sqb + 16) & sm) == sm) ? 0.f : d1; d2 = (((sqb + 32) & sm) == sm) ? 0.f : d2; d3 = (((sqb + 48) & sm) == sm) ? 0.f : d3;
    }
    h0 = b + w0 * u0 + w1 * x0 + w2 * d0; h1 = b + w0 * u1 + w1 * x1 + w2 * d1; h2 = b + w0 * u2 + w1 * x2 + w2 * d2; h3 = b + w0 * u3 + w1 * x3 + w2 * d3;
}

template <bool EDGE> __device__ __forceinline__ void conv_rows(float x0, float x1, float x2, float x3, float top, float bot, bool f0, bool f15, int sqb, int S,
                                                          float w0, float w1, float w2, float b, float& h0, float& h1, float& h2, float& h3) {
    asm volatile("" : "+v"(x0), "+v"(x1), "+v"(x2), "+v"(x3));
    const float p3 = dpp_prev(x3), n0 = dpp_next(x0);
    float u0 = f0 ? top : p3, u1 = x0, u2 = x1, u3 = x2;
    float d0 = x1, d1 = x2, d2 = x3, d3 = f15 ? bot : n0;
    if (EDGE) {
        const int sm = S - 1;
        u0 = ((sqb & sm) == 0) ? 0.f : u0; u1 = (((sqb + 1) & sm) == 0) ? 0.f : u1; u2 = (((sqb + 2) & sm) == 0) ? 0.f : u2; u3 = (((sqb + 3) & sm) == 0) ? 0.f : u3;
        d0 = ((sqb & sm) == sm) ? 0.f : d0; d1 = (((sqb + 1) & sm) == sm) ? 0.f : d1; d2 = (((sqb + 2) & sm) == sm) ? 0.f : d2; d3 = (((sqb + 3) & sm) == sm) ? 0.f : d3;
    }
    h0 = b + w0 * u0 + w1 * x0 + w2 * d0; h1 = b + w0 * u1 + w1 * x1 + w2 * d1; h2 = b + w0 * u2 + w1 * x2 + w2 * d2; h3 = b + w0 * u3 + w1 * x3 + w2 * d3;
}

namespace pg8 {
constexpr int BM = 256, BK = 64, HALF = 128, HTB = HALF * BK * 2, STAGE_BYTES = 8 * HTB, NXCD = 8, WGM = 8;
__device__ __forceinline__ int lds_byte(int r, int c) { const int st = (r >> 4) * 2 + (c >> 5), rr = r & 15, cc = c & 31, ob = rr * 64 + cc * 2; return st * 1024 + (ob ^ (((ob >> 9) & 1) << 5)); }
__device__ __forceinline__ void stage_rc(int b, int& R, int& C) { const int st = b / 1024, sb = b % 1024, swz = sb ^ (((sb >> 9) & 1) << 5); R = (st >> 1) * 16 + swz / 64; C = (st & 1) * 32 + (swz % 64) / 2; }
__device__ __forceinline__ int perm32(int rho) { const int n = rho >> 4, i = rho & 15; return 8 * (i >> 2) + 4 * n + (i & 3); }
struct Unit { int pm, pn; };
constexpr int OVL_TP = 65, OVL_NM = 3 * OVL_TP;
__device__ __forceinline__ void ovl_decode(int pm, int& regbase, int& t, int& S) {
    const int q = pm / OVL_TP; regbase = q * SP; t = pm - OVL_TP * q; S = (q < 2) ? SP : SS;
}
template <bool OVL> __device__ __forceinline__ long tile_row0(int pm) {
    if (!OVL) return (long)pm * 256;
    int seqbase, t, S; ovl_decode(pm, seqbase, t, S); return (long)seqbase + 254 * t - 1;
}
struct Gemm { const bf16_t* A; const bf16_t* Bt; int M, N, K, lda, ldb; };
struct StaticOrder {
    int nM, nN, nwg, G, c;
    __device__ void init(int M_, int N_, int G_, int c_) { nM = M_ / BM; nN = N_ / BM; nwg = nM * nN; G = G_; c = c_; }
    __device__ void init_tiles(int nM_, int nN_, int G_, int c_) { nM = nM_; nN = nN_; nwg = nM * nN; G = G_; c = c_; }
    __device__ bool next(int i, Unit& u) const {
        const long L = (long)i * G + c; if (L >= nwg) return false;
        int wgid = (int)L; { const int q = nwg / NXCD, r = nwg % NXCD, xcd = wgid % NXCD, off = wgid / NXCD; wgid = (xcd < r ? xcd * (q + 1) : r * (q + 1) + (xcd - r) * q) + off; }
        const int nig = WGM * nN, gid = wgid / nig, fm = gid * WGM, gsz = (nM - fm) < WGM ? (nM - fm) : WGM;
        u.pm = fm + ((wgid % nig) % gsz); u.pn = (wgid % nig) / gsz; return true;
    }
};
typedef f32x4 Acc[2][2][4][2];

struct EpiStore {
    bf16_t* O; int ldc;
    __device__ __forceinline__ void operator()(const Acc& acc, const Unit& u, int wr, int wc, int fr, int fq) const {
        const int row0 = u.pm * BM + wr * 64 + fr, col0 = u.pn * BM + wc * 32 + 8 * fq;
#pragma unroll
        for (int ai = 0; ai < 2; ++ai)
#pragma unroll
            for (int m = 0; m < 4; ++m) { bf16_t* rowp = O + (size_t)(row0 + ai * HALF + m * 16) * ldc + col0;
#pragma unroll
                for (int bj = 0; bj < 2; ++bj) { const f32x4 v0 = acc[ai][bj][m][0], v1 = acc[ai][bj][m][1];
                    u32x4 w; w.x = cvtpk(v0[0], v0[1]); w.y = cvtpk(v0[2], v0[3]); w.z = cvtpk(v1[0], v1[1]); w.w = cvtpk(v1[2], v1[3]);
                    *(u32x4*)(rowp + bj * HALF) = w; } }
    }
};
struct EpiZ {
    bf16_t* O; int ldc; float* ssq_q; float* ssq_kv; bf16_t* Kt; const float* cosT; const float* sinT;
    __device__ __forceinline__ void operator()(const Acc& acc, const Unit& u, int wr, int wc, int fr, int fq) const {
        const int row0 = u.pm * BM + wr * 64 + fr, col0 = u.pn * BM + wc * 32 + 8 * fq;
#pragma unroll
        for (int ai = 0; ai < 2; ++ai)
#pragma unroll
            for (int m = 0; m < 4; ++m) { const int row = row0 + ai * HALF + m * 16; bf16_t* rowp = O + (size_t)row * ldc + col0;
#pragma unroll
                for (int bj = 0; bj < 2; ++bj) { const f32x4 v0 = acc[ai][bj][m][0], v1 = acc[ai][bj][m][1];
                    u32x4 w; w.x = cvtpk(v0[0], v0[1]); w.y = cvtpk(v0[2], v0[3]); w.z = cvtpk(v1[0], v1[1]); w.w = cvtpk(v1[2], v1[3]);
                    if (col0 + bj * HALF < ZP) *(u32x4*)(rowp + bj * HALF) = w; }
                if (u.pn <= 1) {
                    float sq = 0.f;
#pragma unroll
                    for (int bj = 0; bj < 2; ++bj) { if (bj == 1 && u.pn == 1) continue;
#pragma unroll
                        for (int n = 0; n < 2; ++n) { const f32x4 v = acc[ai][bj][m][n]; sq += (v[0] * v[0] + v[1] * v[1]) + (v[2] * v[2] + v[3] * v[3]); } }
                    sq += __shfl_xor(sq, 16); sq += __shfl_xor(sq, 32);
                    if (fq == 0) atomicAdd((u.pn == 0 ? ssq_q : ssq_kv) + row, sq);
                    if (u.pn == 1 && wc == 0) {
                        const int sp_ = seqpos(row); const f32x4 c = *(const f32x4*)(cosT + sp_ * 16 + 4 * fq), sn = *(const f32x4*)(sinT + sp_ * 16 + 4 * fq);
                        const f32x4 a = acc[ai][1][m][0], b = acc[ai][1][m][1];
                        u32x4 w; w.x = cvtpk(a[0] * c[0] - a[1] * sn[0], a[0] * sn[0] + a[1] * c[0]); w.y = cvtpk(a[2] * c[1] - a[3] * sn[1], a[2] * sn[1] + a[3] * c[1]);
                        w.z = cvtpk(b[0] * c[2] - b[1] * sn[2], b[0] * sn[2] + b[1] * c[2]); w.w = cvtpk(b[2] * c[3] - b[3] * sn[3], b[2] * sn[3] + b[3] * c[3]);
                        const int gt = row >> 6, r = row & 63;
#pragma unroll
                        for (int h = 0; h < 8; ++h) *(u32x4*)(Kt + ((size_t)((h * NGT + gt) * 12 + 8 + fq)) * 512 + r * 8) = w; }
                }
            }
    }
};
struct EpiQ {
    bf16_t* Q; const float* rstd; const float* cosT; const float* sinT;
    __device__ __forceinline__ void operator()(const Acc& acc, const Unit& u, int wr, int wc, int fr, int fq) const {
        const int row0 = u.pm * BM + wr * 64 + fr, col0 = u.pn * BM + wc * 32 + 8 * fq;
#pragma unroll
        for (int ai = 0; ai < 2; ++ai)
#pragma unroll
            for (int m = 0; m < 4; ++m) { const int row = row0 + ai * HALF + m * 16; const float rs = rsqrtf(rstd[row] * (1.f / 256.f) + EPS) * QSCALE; const int s = seqpos(row);
#pragma unroll
                for (int bj = 0; bj < 2; ++bj) { const int col = col0 + bj * HALF; const int d = col % 96;
                    f32x4 v0 = acc[ai][bj][m][0] * rs, v1 = acc[ai][bj][m][1] * rs;
                    if (d >= 64) { const int i0 = (d - 64) >> 1; const f32x4 c = *(const f32x4*)(cosT + s * 16 + i0), sn = *(const f32x4*)(sinT + s * 16 + i0);
                        const f32x4 a = v0, b = v1;
                        v0[0] = a[0] * c[0] - a[1] * sn[0]; v0[1] = a[0] * sn[0] + a[1] * c[0]; v0[2] = a[2] * c[1] - a[3] * sn[1]; v0[3] = a[2] * sn[1] + a[3] * c[1];
                        v1[0] = b[0] * c[2] - b[1] * sn[2]; v1[1] = b[0] * sn[2] + b[1] * c[2]; v1[2] = b[2] * c[3] - b[3] * sn[3]; v1[3] = b[2] * sn[3] + b[3] * c[3]; }
                    u32x4 w; w.x = cvtpk(v0[0], v0[1]); w.y = cvtpk(v0[2], v0[3]); w.z = cvtpk(v1[0], v1[1]); w.w = cvtpk(v1[2], v1[3]);
                    *(u32x4*)(Q + (size_t)row * QW + col) = w; } }
    }
};
struct EpiKV {
    bf16_t* Kt; bf16_t* Vt; const float* rstd;
    __device__ __forceinline__ void operator()(const Acc& acc, const Unit& u, int wr, int wc, int fr, int fq) const {
        const int row0 = u.pm * BM + wr * 64 + fr, col0 = u.pn * BM + wc * 32 + 8 * fq;
#pragma unroll
        for (int ai = 0; ai < 2; ++ai)
#pragma unroll
            for (int m = 0; m < 4; ++m) { const int row = row0 + ai * HALF + m * 16; const float rs = rsqrtf(rstd[row] * (1.f / 128.f) + EPS); const int gt = row >> 6, r = row & 63;
#pragma unroll
                for (int bj = 0; bj < 2; ++bj) { const int col = col0 + bj * HALF; const f32x4 v0 = acc[ai][bj][m][0] * rs, v1 = acc[ai][bj][m][1] * rs;
                    u32x4 w; w.x = cvtpk(v0[0], v0[1]); w.y = cvtpk(v0[2], v0[3]); w.z = cvtpk(v1[0], v1[1]); w.w = cvtpk(v1[2], v1[3]);
                    bf16_t* dst;
                    if (col < 512) { const int h = col >> 6, d = col & 63; dst = Kt + ((size_t)((h * NGT + gt) * 12 + (d >> 3))) * 512 + r * 8; }
                    else { const int v = col - 512, h = v >> 6, d = v & 63; dst = Vt + ((size_t)((h * NGT + gt) * 8 + (d >> 5) * 4 + (r >> 4))) * 512 + (r & 15) * 32 + (d & 31); }
                    *(u32x4*)dst = w; } }
    }
};

struct EpiConv {
    bf16_t* ACT; const float* cw; const float* cb; LAS float* xch;
#define LOADT(k, b_) { const float* wp_ = cw + chan0 + (k); tw[b_][0] = wp_[0]; tw[b_][1] = wp_[NUP]; tw[b_][2] = wp_[2 * NUP]; tw[b_][3] = cb[chan0 + (k)]; \
                       tw[b_][4] = wp_[DFF]; tw[b_][5] = wp_[NUP + DFF]; tw[b_][6] = wp_[2 * NUP + DFF]; tw[b_][7] = cb[DFF + chan0 + (k)]; }
    template <bool EDGE> __device__ __forceinline__ void compute(Acc& acc, int chan0, int colb, int s0, int S, int wr, int fr) const {
        float tw[2][8];
        LOADT(0, 0)
        const bool f0 = (fr == 0), f15 = (fr == 15);
#pragma unroll
        for (int n = 0; n < 2; ++n)
#pragma unroll
            for (int c = 0; c < 4; ++c) {
                constexpr int dummy_ = 0; (void)dummy_;
                const int k_ = 4 * n + c;
                if (k_ + 1 < 8) LOADT(k_ + 1, (k_ + 1) & 1)
                const float wg0 = tw[k_ & 1][0], wg1 = tw[k_ & 1][1], wg2 = tw[k_ & 1][2], bg = tw[k_ & 1][3], wu0 = tw[k_ & 1][4], wu1 = tw[k_ & 1][5], wu2 = tw[k_ & 1][6], bu = tw[k_ & 1][7];
#pragma unroll
                for (int ai = 0; ai < 2; ++ai) { const int blk = 2 * ai + wr;
                    const int sqb = s0 + 64 * blk + 4 * fr;
                    float gt = 0.f, ut = 0.f, gb = 0.f, ub = 0.f;
                    if (blk > 0) { gt = xch[((blk - 1) * 2 + 1) * 256 + colb + 4 * n + c]; ut = xch[((blk - 1) * 2 + 1) * 256 + 128 + colb + 4 * n + c]; }
                    if (blk < 3) { gb = xch[((blk + 1) * 2 + 0) * 256 + colb + 4 * n + c]; ub = xch[((blk + 1) * 2 + 0) * 256 + 128 + colb + 4 * n + c]; }
                    float hg0, hg1, hg2, hg3, hu0, hu1, hu2, hu3;
                    conv_rows<EDGE>(acc[ai][0][0][n][c], acc[ai][0][1][n][c], acc[ai][0][2][n][c], acc[ai][0][3][n][c], gt, gb, f0, f15, sqb, S, wg0, wg1, wg2, bg, hg0, hg1, hg2, hg3);
                    conv_rows<EDGE>(acc[ai][1][0][n][c], acc[ai][1][1][n][c], acc[ai][1][2][n][c], acc[ai][1][3][n][c], ut, ub, f0, f15, sqb, S, wu0, wu1, wu2, bu, hu0, hu1, hu2, hu3);
                    float r0 = gelu_tanh(hg0) * hu0, r1 = gelu_tanh(hg1) * hu1, r2 = gelu_tanh(hg2) * hu2, r3 = gelu_tanh(hg3) * hu3;
                    asm volatile("" : "+v"(r0), "+v"(r1), "+v"(r2), "+v"(r3));
                    acc[ai][0][0][n][c] = r0; acc[ai][0][1][n][c] = r1; acc[ai][0][2][n][c] = r2; acc[ai][0][3][n][c] = r3;
                    __builtin_amdgcn_sched_barrier(0);
                }
            }
    }
    __device__ __forceinline__ void operator()(Acc& acc, const Unit& u, int wr, int wc, int fr, int fq) const {
        int seqbase, t, S; ovl_decode(u.pm, seqbase, t, S);
        const int s0 = 254 * t - 1;
        const int colb = wc * 32 + 8 * fq;
        const int chan0 = u.pn * 128 + colb;
#pragma unroll
        for (int ai = 0; ai < 2; ++ai) { const int blk = 2 * ai + wr;
            if (fr == 0) {
#pragma unroll
                for (int bj = 0; bj < 2; ++bj)
#pragma unroll
                    for (int n = 0; n < 2; ++n) *(LAS f32x4*)(xch + (blk * 2 + 0) * 256 + bj * 128 + colb + 4 * n) = acc[ai][bj][0][n]; }
            if (fr == 15) {
#pragma unroll
                for (int bj = 0; bj < 2; ++bj)
#pragma unroll
                    for (int n = 0; n < 2; ++n) *(LAS f32x4*)(xch + (blk * 2 + 1) * 256 + bj * 128 + colb + 4 * n) = acc[ai][bj][3][n]; } }
        asm volatile("s_waitcnt lgkmcnt(0)\n\ts_barrier" ::: "memory");
        if ((s0 < 0) || ((s0 & (S - 1)) > S - 258)) compute<true>(acc, chan0, colb, s0, S, wr, fr); else compute<false>(acc, chan0, colb, s0, S, wr, fr);
#undef LOADT
#pragma unroll
        for (int ai = 0; ai < 2; ++ai) { const int blk = 2 * ai + wr;
#pragma unroll
            for (int m = 0; m < 4; ++m) { const int R = 64 * blk + 4 * fr + m, sq = s0 + R;
                if (R >= 1 && R <= 254 && sq < SP) { const f32x4 v0 = acc[ai][0][m][0], v1 = acc[ai][0][m][1];
                    u32x4 w; w.x = cvtpk(v0[0], v0[1]); w.y = cvtpk(v0[2], v0[3]); w.z = cvtpk(v1[0], v1[1]); w.w = cvtpk(v1[2], v1[3]);
                    *(u32x4*)(ACT + (size_t)(seqbase + sq) * DFF + chan0) = w; } }
        }
    }
};

template <class Epi, bool OVL = false>
__device__ __forceinline__ void gemm_phase(LAS unsigned char* lds, const Gemm g, const StaticOrder& S, const Epi& E, const int wid) {
    const int lane = lane_id_asm(), tid = wid * 64 + lane;
    const int wr = wid >> 2, wc = wid & 3, fr = lane & 15, fq = lane >> 4;
    const int nt = g.K / BK;
    const char* gA = (const char*)g.A; const char* gB = (const char*)g.Bt;
    asm volatile("" : "+s"(gA), "+s"(gB));
    unsigned voffA[2], voffB[2];
#pragma unroll
    for (int i = 0; i < 2; ++i) { int R, C; stage_rc(tid * 16 + i * 8192, R, C); const int Rb = (R & ~31) + perm32(R & 31);
        const int Ra = OVL ? ((R & 64) + 4 * (R & 15) + ((R >> 4) & 3)) : R;
        voffA[i] = (unsigned)(Ra * g.lda + C) * 2u; voffB[i] = (unsigned)(Rb * g.ldb + C) * 2u; }
    const size_t kstep = (size_t)(BK * 2);
    const size_t hstepA = (size_t)HALF * g.lda * 2, hstepB = (size_t)HALF * g.ldb * 2;
    const size_t tstepB = 2 * hstepB;
    const unsigned ldsw = (unsigned)wid * 1024u;
    const int aoff = lds_byte(wr * 64 + fr, fq * 8), boff = lds_byte(wc * 32 + fr, fq * 8);
#define PG8_SA(b, h) (((b) * 2 + (h)) * HTB)
#define PG8_SB(b, h) ((4 + (b) * 2 + (h)) * HTB)
#define PG8_STAGE(bufoff, gbase, voff) do { _Pragma("unroll") for (int _i = 0; _i < 2; ++_i) \
        __builtin_amdgcn_global_load_lds((const unsigned*)((const char*)(gbase) + (voff)[_i]), (LAS unsigned*)(lds + (bufoff) + ldsw + _i * 8192), 16, 0, 0); } while (0)
#define PG8_LDA(dst, b, h) do { _Pragma("unroll") for (int m = 0; m < 4; ++m) _Pragma("unroll") for (int k = 0; k < 2; ++k) dst[m][k] = *(const LAS bf16x8*)(lds + PG8_SA(b, h) + aoff + m * 2048 + k * 1024); } while (0)
#define PG8_LDB(dst, b, h) do { _Pragma("unroll") for (int n = 0; n < 2; ++n) _Pragma("unroll") for (int k = 0; k < 2; ++k) dst[n][k] = *(const LAS bf16x8*)(lds + PG8_SB(b, h) + boff + n * 2048 + k * 1024); } while (0)
#define PG8_MMA(ai, bj, At, Bt) do { __builtin_amdgcn_s_setprio(1); _Pragma("unroll") for (int m = 0; m < 4; ++m) _Pragma("unroll") for (int n = 0; n < 2; ++n) _Pragma("unroll") for (int k = 0; k < 2; ++k) \
        acc[ai][bj][m][n] = __builtin_amdgcn_mfma_f32_16x16x32_bf16(Bt[n][k], At[m][k], acc[ai][bj][m][n], 0, 0, 0); __builtin_amdgcn_s_setprio(0); } while (0)
#define PG8_WAIT_V(n) asm volatile("s_waitcnt vmcnt(" #n ")" ::: "memory")
#define PG8_WAIT_L(n) asm volatile("s_waitcnt lgkmcnt(" #n ")" ::: "memory")
#define PG8_BAR __builtin_amdgcn_s_barrier()
#define PG8_SCHED __builtin_amdgcn_sched_barrier(0)
    Unit cur, nxt; int ui = 0;
    if (!S.next(0, cur)) return;
    Acc acc;
#pragma unroll
    for (int a = 0; a < 2; ++a)
#pragma unroll
        for (int b = 0; b < 2; ++b)
#pragma unroll
            for (int m = 0; m < 4; ++m)
#pragma unroll
                for (int n = 0; n < 2; ++n) acc[a][b][m][n] = (f32x4){0.f, 0.f, 0.f, 0.f};
    bf16x8 At[4][2], B0[2][2], B1[2][2];
    const long rowB = (long)g.lda * 2; const char* cA = gA + tile_row0<OVL>(cur.pm) * rowB; const char* cB = gB + (size_t)cur.pn * tstepB;
    PG8_STAGE(PG8_SB(0, 0), cB, voffB); PG8_STAGE(PG8_SB(0, 1), cB + hstepB, voffB); PG8_STAGE(PG8_SA(0, 0), cA, voffA); PG8_STAGE(PG8_SA(0, 1), cA + hstepA, voffA);
    if (wr == 1) PG8_BAR;
    PG8_WAIT_V(2); PG8_BAR;
    PG8_STAGE(PG8_SB(1, 0), cB + kstep, voffB); PG8_STAGE(PG8_SA(1, 0), cA + kstep, voffA); PG8_STAGE(PG8_SB(1, 1), cB + hstepB + kstep, voffB);
    PG8_WAIT_V(6); PG8_BAR;
    for (;;) {
        const bool has_next = S.next(ui + 1, nxt);
        const char* nA = has_next ? gA + tile_row0<OVL>(nxt.pm) * rowB : cA; const char* nB = has_next ? gB + (size_t)nxt.pn * tstepB : cB;
        for (int t = 0; t < nt; t += 2) {
            const bool last = (t == nt - 2);
            const char* a1 = cA + (size_t)(t + 1) * kstep;
            const char* a2 = last ? nA : cA + (size_t)(t + 2) * kstep; const char* b2 = last ? nB : cB + (size_t)(t + 2) * kstep;
            const char* a3 = a2 + kstep; const char* b3 = b2 + kstep;
            PG8_LDB(B0, 0, 0); PG8_LDB(B1, 0, 1); PG8_SCHED; PG8_LDA(At, 0, 0); PG8_STAGE(PG8_SA(1, 1), a1 + hstepA, voffA);
            PG8_WAIT_V(8); PG8_WAIT_L(0); PG8_BAR; PG8_MMA(0, 0, At, B0); PG8_MMA(0, 1, At, B1); PG8_BAR; PG8_SCHED;
            PG8_LDA(At, 0, 1); PG8_STAGE(PG8_SB(0, 0), b2, voffB); PG8_STAGE(PG8_SB(0, 1), b2 + hstepB, voffB); PG8_STAGE(PG8_SA(0, 0), a2, voffA);
            PG8_WAIT_V(8); PG8_WAIT_L(0); PG8_BAR; PG8_MMA(1, 0, At, B0); PG8_MMA(1, 1, At, B1); PG8_BAR; PG8_SCHED;
            PG8_LDB(B0, 1, 0); PG8_LDB(B1, 1, 1); PG8_SCHED; PG8_LDA(At, 1, 0); PG8_STAGE(PG8_SA(0, 1), a2 + hstepA, voffA);
            PG8_WAIT_V(8); PG8_WAIT_L(0); PG8_BAR; PG8_MMA(0, 0, At, B0); PG8_MMA(0, 1, At, B1); PG8_BAR; PG8_SCHED;
            PG8_LDA(At, 1, 1); PG8_STAGE(PG8_SB(1, 0), b3, voffB); PG8_STAGE(PG8_SB(1, 1), b3 + hstepB, voffB); PG8_STAGE(PG8_SA(1, 0), a3, voffA);
            PG8_WAIT_V(8); PG8_WAIT_L(0); PG8_BAR; PG8_MMA(1, 0, At, B0); PG8_MMA(1, 1, At, B1); PG8_BAR; PG8_SCHED;
        }
        if (wr == 0) PG8_BAR;
        { const int l2 = lane_id_asm(); E(acc, cur, wr, wc, l2 & 15, l2 >> 4); }
        if (!has_next) break;
#pragma unroll
        for (int a = 0; a < 2; ++a)
#pragma unroll
            for (int b = 0; b < 2; ++b)
#pragma unroll
                for (int m = 0; m < 4; ++m)
#pragma unroll
                    for (int n = 0; n < 2; ++n) acc[a][b][m][n] = (f32x4){0.f, 0.f, 0.f, 0.f};
        cur = nxt; cA = nA; cB = nB; ++ui;
        if (wr == 1) PG8_BAR;
    }
    PG8_WAIT_V(0);
    PG8_BAR;
#undef PG8_SA
#undef PG8_SB
#undef PG8_STAGE
#undef PG8_LDA
#undef PG8_LDB
#undef PG8_MMA
#undef PG8_WAIT_V
#undef PG8_WAIT_L
#undef PG8_BAR
#undef PG8_SCHED
}
}

namespace mla2 {
constexpr int QBLK = 32, KVBLK = 64, NSLOT = 3, KSLOT = 12288, VSLOT = 8192;
constexpr int LDS_K = 0, LDS_V = NSLOT * KSLOT, LDS_WS = LDS_V + NSLOT * VSLOT, LDS_OST = LDS_WS + 8 * 64 * 4, LDS_BYTES = LDS_OST + 8 * 4096;
constexpr int THRL = 8;
typedef const LAS char* lds_cptr;
typedef short v4i16_t __attribute__((ext_vector_type(4)));
#define SBAR() __builtin_amdgcn_sched_barrier(0)
__device__ __forceinline__ int crow(int r, int hi) { return (r & 3) + 8 * (r >> 2) + 4 * hi; }
__device__ __forceinline__ void glds16(const void* gsrc, unsigned lds_dst) { unsigned keep;
    asm volatile("s_mov_b32 %0, m0\n\ts_mov_b32 m0, %2\n\ts_nop 0\n\tglobal_load_lds_dwordx4 %1, off\n\ts_mov_b32 m0, %0" : "=&s"(keep) : "v"(gsrc), "s"(lds_dst) : "memory"); }
__device__ __forceinline__ s16x4 vtr(lds_cptr p) { return __builtin_bit_cast(s16x4, __builtin_amdgcn_ds_read_tr16_b64_v4i16((LAS v4i16_t*)p)); }
__device__ __forceinline__ void kload2(bf16x8* kf, lds_cptr kp, int j) { kf[2 * j] = *(const LAS bf16x8*)(kp + j * 2048); kf[2 * j + 1] = *(const LAS bf16x8*)(kp + j * 2048 + 512); }
#define MX3(a, b, c) __builtin_fmaxf(__builtin_fmaxf((a), (b)), (c))
__device__ __forceinline__ float rowmax(const f32x16& p0, const f32x16& p1) {
    float a = MX3(p0[0], p0[1], p1[0]), b = MX3(p0[2], p0[3], p1[1]); a = MX3(a, p1[2], p1[3]);
#pragma unroll
    for (int r = 4; r < 16; r += 4) { a = MX3(a, p0[r], p0[r + 1]); b = MX3(b, p0[r + 2], p0[r + 3]); a = MX3(a, p1[r], p1[r + 1]); b = MX3(b, p1[r + 2], p1[r + 3]); }
    float rm = __builtin_fmaxf(a, b);
    auto rr = __builtin_amdgcn_permlane32_swap(__float_as_uint(rm), __float_as_uint(rm), false, false);
    return __builtin_fmaxf(__uint_as_float(rr[0]), __uint_as_float(rr[1]));
}
#define WAITB(NK, NV) do { if (kw) asm volatile("s_waitcnt vmcnt(" #NK ") lgkmcnt(0)\n\ts_barrier" ::: "memory"); else asm volatile("s_waitcnt vmcnt(" #NV ") lgkmcnt(0)\n\ts_barrier" ::: "memory"); } while (0)

__device__ __forceinline__ void attn_unit(const bf16_t* __restrict__ Qb, const bf16_t* __restrict__ Kh, const bf16_t* __restrict__ Vh, bf16_t* __restrict__ Ob, int seq, LAS char* shm, const int wid) {
    const int lane = lane_id_asm(), r32 = lane & 31, hi = lane >> 5;
    const bool kw = wid < 4;
    const unsigned lds0 = (unsigned)(size_t)shm;
    LAS float* wsf = (LAS float*)(shm + LDS_WS) + wid * 64;
    const bf16_t* ksrc = Kh + wid * 512 + lane * 8;
    const int vi0 = 2 * (wid & 3);
    const bf16_t* vsrc0 = Vh + vi0 * 512 + lane * 8;
    const bf16_t* vsrc1 = vsrc0 + 512;
    const unsigned kdst = lds0 + LDS_K + wid * 1024, vdst = lds0 + LDS_V + vi0 * 1024;
#define DMA_K(t, si) do { if (kw) { const bf16_t* s_ = ksrc + (long)(t) * 6144; const unsigned d_ = (unsigned)__builtin_amdgcn_readfirstlane(kdst + (si) * KSLOT); \
        glds16(s_, d_); glds16(s_ + 2048, d_ + 4096); glds16(s_ + 4096, d_ + 8192); } } while (0)
#define DMA_V(t, si) do { if (!kw) { const unsigned d_ = (unsigned)__builtin_amdgcn_readfirstlane(vdst + (si) * VSLOT); \
        glds16(vsrc0 + (long)(t) * 4096, d_); glds16(vsrc1 + (long)(t) * 4096, d_ + 1024); } } while (0)
    const lds_cptr shm3 = (lds_cptr)shm;
    const lds_cptr kp0 = shm3 + LDS_K + hi * 1024 + r32 * 16;
    const lds_cptr vp0 = shm3 + LDS_V + ((lane >> 4) & 1) * 32 + (lane & 3) * 8 + (4 * hi + ((lane & 15) >> 2)) * 64;
    const int NT = seq / KVBLK;
    bf16x8 qr[6];
    { const bf16_t* Qw = Qb + (long)(wid * QBLK + r32) * QW + hi * 8;
#pragma unroll
      for (int d0 = 0; d0 < 6; ++d0) qr[d0] = *(const bf16x8*)(Qw + d0 * 16); }
    asm volatile("s_waitcnt vmcnt(0)" ::: "memory");
    DMA_K(0, 0); DMA_V(0, 0); DMA_K(1, 1); DMA_K(2, 2);
    float mhat = 0.f, l_reg = 0.f; f32x16 o[2]; o[0] = f32x16{}; o[1] = f32x16{}; f32x16 negm = f32x16{}; asm volatile("" : "+v"(negm));
    f32x16 pA0, pA1, pB0, pB1; bf16x8 kf[12];
    bool resc = false;
    WAITB(6, 2);
    {
        kload2(kf, kp0, 0); kload2(kf, kp0, 1); kload2(kf, kp0, 2); kload2(kf, kp0, 3); kload2(kf, kp0, 4); kload2(kf, kp0, 5);
#pragma unroll
        for (int d0 = 0; d0 < 6; ++d0) {
            if (d0 == 0) { pA0 = __builtin_amdgcn_mfma_f32_32x32x16_bf16(kf[0], qr[0], negm, 0, 0, 0); pA1 = __builtin_amdgcn_mfma_f32_32x32x16_bf16(kf[1], qr[0], negm, 0, 0, 0); }
            else { pA0 = __builtin_amdgcn_mfma_f32_32x32x16_bf16(kf[2 * d0], qr[d0], pA0, 0, 0, 0); pA1 = __builtin_amdgcn_mfma_f32_32x32x16_bf16(kf[2 * d0 + 1], qr[d0], pA1, 0, 0, 0); } }
        const float rm = rowmax(pA0, pA1); mhat = rm;
#pragma unroll
        for (int r = 0; r < 16; ++r) { pA0[r] = __builtin_amdgcn_exp2f(pA0[r] - rm); pA1[r] = (r < 8) ? __builtin_amdgcn_exp2f(pA1[r] - rm) : (pA1[r] - rm); }
#pragma unroll
        for (int r = 0; r < 16; ++r) negm[r] = -mhat;
        asm volatile("" : "+v"(negm));
    }
    WAITB(0, 0);
    DMA_K(3, 0); DMA_V(1, 1);
    int sp = 0, sc = 1, sn = 2;
    kload2(kf, kp0 + sc * KSLOT, 0); kload2(kf, kp0 + sc * KSLOT, 1); kload2(kf, kp0 + sc * KSLOT, 2); kload2(kf, kp0 + sc * KSLOT, 3); kload2(kf, kp0 + sc * KSLOT, 4); kload2(kf, kp0 + sc * KSLOT, 5);
    WAITB(3, 2);
#define ROT() do { sp = sc; sc = sn; sn = (sn == NSLOT - 1) ? 0 : sn + 1; } while (0)
#define RESC() do { if (resc) { asm volatile("s_waitcnt lgkmcnt(0)" ::: "memory"); \
        _Pragma("unroll") for (int d_ = 0; d_ < 2; ++d_) _Pragma("unroll") for (int r = 0; r < 16; ++r) o[d_][r] *= wsf[crow(r, hi)]; } } while (0)
    s16x4 vlo[4], vhi[4]; u32x4 pw0, pw1, pw2, pw3;
#define PKW(P, B) cvtpk(P[B], P[B + 1])
#define PAF(k) __builtin_bit_cast(bf16x8, pw##k)
#define VFR(i) (bf16x8){vlo[(i) & 3][0], vlo[(i) & 3][1], vlo[(i) & 3][2], vlo[(i) & 3][3], vhi[(i) & 3][0], vhi[(i) & 3][1], vhi[(i) & 3][2], vhi[(i) & 3][3]}
#define PIN(x) asm volatile("" : "+v"(x))
#define EX(v) __builtin_amdgcn_exp2f(v)
#define VRD(i) do { vlo[(i) & 3] = vtr(vp_ + (((i) >> 2) * 4096 + ((i) & 3) * 1024)); vhi[(i) & 3] = vtr(vp_ + (((i) >> 2) * 4096 + ((i) & 3) * 1024 + 512)); } while (0)
#define KRD(G, j) do { if (G) { kload2(kf, kp0 + sn * KSLOT, j); SBAR(); } } while (0)
#define QK(C, i, d, CIN) C = __builtin_amdgcn_mfma_f32_32x32x16_bf16(kf[i], qr[d], CIN, 0, 0, 0)
#define GAPE(MF, E0, E1, E2) do { MF; E0 = EX(E0); E1 = EX(E1); E2 = EX(E2); PIN(E0); PIN(E1); PIN(E2); SBAR(); } while (0)
#define GAPB(MF, X, B) do { MF; X[B] = EX(X[B]); X[B + 1] = EX(X[B + 1]); X[B + 2] = EX(X[B + 2]); X[B + 3] = EX(X[B + 3]); PIN(X); SBAR(); } while (0)
#define STEP(C0, C1, P0, P1, t, GK, GV, GL) do { SBAR(); \
    const lds_cptr vp_ = vp0 + sp * VSLOT; float sacc; \
    VRD(0); SBAR(); QK(C0, 0, 0, negm);  sacc = P0[0] + P0[1]; sacc += P0[2]; sacc += P0[3]; PIN(sacc); pw0[0] = PKW(P0, 0); PIN(pw0); SBAR(); \
    VRD(1); SBAR(); QK(C1, 1, 0, negm);  sacc += P0[4]; sacc += P0[5]; sacc += P0[6]; PIN(sacc); pw0[1] = PKW(P0, 2); PIN(pw0); SBAR(); \
    VRD(2); SBAR(); QK(C0, 2, 1, C0);    sacc += P0[7]; sacc += P0[8]; sacc += P0[9]; PIN(sacc); pw0[2] = PKW(P0, 4); PIN(pw0); SBAR(); \
    VRD(3); SBAR(); QK(C1, 3, 1, C1);    sacc += P0[10]; sacc += P0[11]; sacc += P0[12]; PIN(sacc); pw0[3] = PKW(P0, 6); PIN(pw0); SBAR(); \
    QK(C0, 4, 2, C0);    P1[8] = EX(P1[8]); sacc += P0[13]; sacc += P0[14]; sacc += P0[15]; PIN(sacc); pw1[0] = PKW(P0, 8); PIN(pw1); SBAR(); \
    QK(C1, 5, 2, C1);    P1[9] = EX(P1[9]); sacc += P1[0]; sacc += P1[1]; sacc += P1[2]; PIN(sacc); pw1[1] = PKW(P0, 10); PIN(pw1); SBAR(); \
    QK(C0, 6, 3, C0);    P1[10] = EX(P1[10]); sacc += P1[3]; sacc += P1[4]; sacc += P1[5]; PIN(sacc); pw1[2] = PKW(P0, 12); PIN(pw1); SBAR(); \
    QK(C1, 7, 3, C1);    P1[11] = EX(P1[11]); sacc += P1[6]; sacc += P1[7]; PIN(sacc); pw1[3] = PKW(P0, 14); PIN(pw1); SBAR(); \
    QK(C0, 8, 4, C0);    P1[12] = EX(P1[12]); P1[13] = EX(P1[13]); sacc += P1[8]; sacc += P1[9]; PIN(sacc); pw2[0] = PKW(P1, 0); pw2[1] = PKW(P1, 2); PIN(pw2); SBAR(); \
    QK(C1, 9, 4, C1);    P1[14] = EX(P1[14]); P1[15] = EX(P1[15]); sacc += P1[10]; sacc += P1[11]; PIN(sacc); pw2[2] = PKW(P1, 4); pw2[3] = PKW(P1, 6); PIN(pw2); SBAR(); \
    QK(C0, 10, 5, C0);   sacc += P1[12]; sacc += P1[13]; PIN(sacc); pw3[0] = PKW(P1, 8); pw3[1] = PKW(P1, 10); PIN(pw3); SBAR(); \
    QK(C1, 11, 5, C1);   sacc += P1[14]; sacc += P1[15]; PIN(sacc); pw3[2] = PKW(P1, 12); pw3[3] = PKW(P1, 14); PIN(pw3); SBAR(); \
    l_reg += sacc; \
    if (GK) { DMA_K((t) + 3, sc); } if (GV) { DMA_V((t) + 1, sn); } \
    { float a = MX3(C0[0], C0[1], C0[2]), b = MX3(C0[3], C0[4], C0[5]), c = MX3(C1[0], C1[1], C1[2]), d = MX3(C1[3], C1[4], C1[5]);   \
      a = MX3(a, C0[6], C0[7]); b = MX3(b, C0[8], C0[9]); c = MX3(c, C1[6], C1[7]); d = MX3(d, C1[8], C1[9]); \
      a = MX3(a, C0[10], C0[11]); b = MX3(b, C0[12], C0[13]); c = MX3(c, C1[10], C1[11]); d = MX3(d, C1[12], C1[13]); \
      a = MX3(a, C0[14], C0[15]); c = MX3(c, C1[14], C1[15]); \
      float rm = MX3(a, b, __builtin_fmaxf(c, d)); { auto rr = __builtin_amdgcn_permlane32_swap(__float_as_uint(rm), __float_as_uint(rm), false, false); rm = __builtin_fmaxf(__uint_as_float(rr[0]), __uint_as_float(rr[1])); } \
      resc = false; \
      if (__builtin_expect(__any(rm > (float)THRL), 0)) { const float dl = __builtin_fmaxf(rm, 0.f); mhat += dl; \
        _Pragma("unroll") for (int r = 0; r < 16; ++r) { C0[r] -= dl; C1[r] -= dl; } \
        _Pragma("unroll") for (int r = 0; r < 16; ++r) negm[r] = -mhat; asm volatile("" : "+v"(negm)); \
        const float f = __builtin_amdgcn_exp2f(-dl); l_reg *= f; if (hi == 0) wsf[r32] = f; resc = true; } } \
    SBAR(); \
    GAPE(o[0] = __builtin_amdgcn_mfma_f32_32x32x16_bf16(PAF(0), VFR(0), o[0], 0, 0, 0), C0[0], C0[1], C0[2]); VRD(4); SBAR(); \
    KRD(GL, 0); GAPE(o[0] = __builtin_amdgcn_mfma_f32_32x32x16_bf16(PAF(1), VFR(1), o[0], 0, 0, 0), C0[3], C0[4], C0[5]); VRD(5); SBAR(); \
    KRD(GL, 1); GAPE(o[0] = __builtin_amdgcn_mfma_f32_32x32x16_bf16(PAF(2), VFR(2), o[0], 0, 0, 0), C0[6], C0[7], C0[8]); VRD(6); SBAR(); \
    KRD(GL, 2); GAPE(o[0] = __builtin_amdgcn_mfma_f32_32x32x16_bf16(PAF(3), VFR(3), o[0], 0, 0, 0), C0[9], C0[10], C0[11]); VRD(7); SBAR(); \
    KRD(GL, 3); GAPE(o[1] = __builtin_amdgcn_mfma_f32_32x32x16_bf16(PAF(0), VFR(4), o[1], 0, 0, 0), C0[12], C0[13], C0[14]); \
    KRD(GL, 4); GAPE(o[1] = __builtin_amdgcn_mfma_f32_32x32x16_bf16(PAF(1), VFR(5), o[1], 0, 0, 0), C0[15], C1[0], C1[1]); \
    KRD(GL, 5); GAPE(o[1] = __builtin_amdgcn_mfma_f32_32x32x16_bf16(PAF(2), VFR(6), o[1], 0, 0, 0), C1[2], C1[3], C1[4]); \
    GAPE(o[1] = __builtin_amdgcn_mfma_f32_32x32x16_bf16(PAF(3), VFR(7), o[1], 0, 0, 0), C1[5], C1[6], C1[7]);   \
    } while (0)
    int t = 1;
    for (; t + 4 < NT; t += 2) {
        STEP(pB0, pB1, pA0, pA1, t, true, true, true);       WAITB(3, 2); RESC(); ROT();
        STEP(pA0, pA1, pB0, pB1, t + 1, true, true, true);   WAITB(3, 2); RESC(); ROT();
    }
    STEP(pB0, pB1, pA0, pA1, t, false, true, true);       WAITB(0, 2); RESC(); ROT();
    STEP(pA0, pA1, pB0, pB1, t + 1, false, true, true);   WAITB(0, 0); RESC(); ROT();
    STEP(pB0, pB1, pA0, pA1, NT - 1, false, false, false); RESC();
    {
#pragma unroll
        for (int r = 8; r < 16; ++r) pB1[r] = __builtin_amdgcn_exp2f(pB1[r]);
        float sacc = pB0[0] + pB0[1];
#pragma unroll
        for (int r = 2; r < 16; ++r) sacc += pB0[r];
#pragma unroll
        for (int r = 0; r < 16; ++r) sacc += pB1[r];
        l_reg += sacc;
        pw0 = (u32x4){PKW(pB0, 0), PKW(pB0, 2), PKW(pB0, 4), PKW(pB0, 6)}; pw1 = (u32x4){PKW(pB0, 8), PKW(pB0, 10), PKW(pB0, 12), PKW(pB0, 14)};
        pw2 = (u32x4){PKW(pB1, 0), PKW(pB1, 2), PKW(pB1, 4), PKW(pB1, 6)}; pw3 = (u32x4){PKW(pB1, 8), PKW(pB1, 10), PKW(pB1, 12), PKW(pB1, 14)};
        const lds_cptr vp_ = vp0 + sc * VSLOT;
        VRD(0); VRD(1); VRD(2); VRD(3);
        o[0] = __builtin_amdgcn_mfma_f32_32x32x16_bf16(PAF(0), VFR(0), o[0], 0, 0, 0); o[0] = __builtin_amdgcn_mfma_f32_32x32x16_bf16(PAF(1), VFR(1), o[0], 0, 0, 0);
        o[0] = __builtin_amdgcn_mfma_f32_32x32x16_bf16(PAF(2), VFR(2), o[0], 0, 0, 0); o[0] = __builtin_amdgcn_mfma_f32_32x32x16_bf16(PAF(3), VFR(3), o[0], 0, 0, 0);
        SBAR(); VRD(4); VRD(5); VRD(6); VRD(7);
        o[1] = __builtin_amdgcn_mfma_f32_32x32x16_bf16(PAF(0), VFR(4), o[1], 0, 0, 0); o[1] = __builtin_amdgcn_mfma_f32_32x32x16_bf16(PAF(1), VFR(5), o[1], 0, 0, 0);
        o[1] = __builtin_amdgcn_mfma_f32_32x32x16_bf16(PAF(2), VFR(6), o[1], 0, 0, 0); o[1] = __builtin_amdgcn_mfma_f32_32x32x16_bf16(PAF(3), VFR(7), o[1], 0, 0, 0);
    }
    { auto rr = __builtin_amdgcn_permlane32_swap(__float_as_uint(l_reg), __float_as_uint(l_reg), false, false); l_reg = __uint_as_float(rr[0]) + __uint_as_float(rr[1]); }
    if (hi == 0) wsf[32 + r32] = l_reg;
    asm volatile("s_waitcnt lgkmcnt(0)" ::: "memory");
    float rli[16];
#pragma unroll
    for (int r = 0; r < 16; ++r) rli[r] = __builtin_amdgcn_rcpf(wsf[32 + crow(r, hi)]);
    bf16_t* Ow = Ob + (long)(wid * QBLK) * DM;
    {   LAS bf16_t* stg = (LAS bf16_t*)(shm + LDS_OST) + wid * 2048;
#pragma unroll
        for (int r = 0; r < 16; ++r) { const int orow = crow(r, hi);
#pragma unroll
            for (int d0 = 0; d0 < 2; ++d0) stg[orow * 64 + d0 * 32 + r32] = (bf16_t)(cvtpk(o[d0][r] * rli[r], 0.f) & 0xffffu); }
        asm volatile("s_waitcnt lgkmcnt(0)" ::: "memory");
#pragma unroll
        for (int i = 0; i < 4; ++i) { const int row = i * 8 + (lane >> 3), ch = lane & 7; const u32x4 v = *(const LAS u32x4*)(stg + row * 64 + ch * 8); *(u32x4*)(Ow + (long)row * DM + ch * 8) = v; } }
    asm volatile("s_waitcnt vmcnt(0) lgkmcnt(0)\n\ts_barrier" ::: "memory");
#undef DMA_K
#undef DMA_V
#undef ROT
#undef RESC
#undef PKW
#undef PAF
#undef VFR
#undef PIN
#undef EX
#undef VRD
#undef KRD
#undef QK
#undef GAPB
#undef GAPE
#undef STEP
}
#undef SBAR
#undef MX3
#undef WAITB
}

namespace na {
constexpr int VP = 144, VBUF = 32 * VP;
constexpr int LDS_RPB = 0, LDS_VB = 16384, LDS_BYTES = LDS_VB + 8 * 2 * VBUF;
typedef short v4i16_t __attribute__((ext_vector_type(4)));
__device__ __forceinline__ void unit(const bf16_t* __restrict__ Z, bf16_t* __restrict__ MIX, const LAS float* rpb, LAS char* vbuf, int tokbase, int rows, int r, int j, int h) {
    const int lane = lane_id_asm();
    const int q = lane & 15, g = lane >> 4;
    const int rs = min(max(r - 4, 0), rows - 8);
    const int bcs = min(max(16 * j - 8, 0), 32);
    const int qtok = tokbase + r * 64 + 16 * j + q;
    const bf16_t* qp = Z + (size_t)qtok * ZP + Z_NQ + h * 64 + 8 * g;
    const bf16x8 qf0 = *(const bf16x8*)qp, qf1 = *(const bf16x8*)(qp + 32);
    const bf16_t* vsrc = Z + (size_t)(tokbase + rs * 64 + bcs) * ZP + Z_NV + h * 64;
    bf16x8 vr[2][4];
#define NA_VLOAD(s) do { _Pragma("unroll") for (int it = 0; it < 4; ++it) { const int id = it * 64 + lane; vr[(s) & 1][it] = *(const bf16x8*)(vsrc + (size_t)((s) * 64 + (id >> 3)) * ZP + (id & 7) * 8); } } while (0)
#define NA_VWRITE(b) do { _Pragma("unroll") for (int it = 0; it < 4; ++it) { const int id = it * 64 + lane; *(LAS bf16x8*)(vbuf + ((b) & 1) * VBUF + (id >> 3) * VP + (id & 7) * 16) = vr[(b) & 1][it]; } } while (0)
    NA_VLOAD(0); NA_VLOAD(1);
    f32x4 acc[16];
    const bf16_t* kbase = Z + (size_t)(tokbase + rs * 64 + bcs + q) * ZP + Z_NK + h * 64 + 8 * g;
#pragma unroll
    for (int t = 0; t < 16; ++t) {
        const bf16_t* kp = kbase + (size_t)((t >> 1) * 64 + 16 * (t & 1)) * ZP;
        const bf16x8 k0 = *(const bf16x8*)kp, k1 = *(const bf16x8*)(kp + 32);
        f32x4 a = {0.f, 0.f, 0.f, 0.f};
        a = __builtin_amdgcn_mfma_f32_16x16x32_bf16(k0, qf0, a, 0, 0, 0);
        a = __builtin_amdgcn_mfma_f32_16x16x32_bf16(k1, qf1, a, 0, 0, 0);
        acc[t] = a;
    }
    const int qcol = 16 * j + q, qs = min(max(qcol - 8, 0), 48);
    float mx = -INFINITY;
#pragma unroll
    for (int t = 0; t < 16; ++t) {
        const int dr = rs + (t >> 1) - r + 7;
#pragma unroll
        for (int i = 0; i < 4; ++i) {
            const int kcol = bcs + 16 * (t & 1) + 4 * g + i;
            const bool valid = (kcol >= qs) && (kcol < qs + 16);
            const int dc = min(max(kcol - qcol + 15, 0), 30);
            float bias = rpb[dr * 31 + dc];
            asm volatile("" : "+v"(bias));
            const float s = valid ? (acc[t][i] * 0.125f + bias) * LOG2E : -INFINITY;
            acc[t][i] = s; mx = fmaxf(mx, s);
        }
    }
    mx = fmaxf(mx, __shfl_xor(mx, 16)); mx = fmaxf(mx, __shfl_xor(mx, 32));
    float l = 0.f;
#pragma unroll
    for (int t = 0; t < 16; ++t)
#pragma unroll
        for (int i = 0; i < 4; ++i) { const float p = __builtin_amdgcn_exp2f(acc[t][i] - mx); acc[t][i] = p; l += p; }
    l += __shfl_xor(l, 16); l += __shfl_xor(l, 32);
    f32x4 o[4];
#pragma unroll
    for (int db = 0; db < 4; ++db) o[db] = (f32x4){0.f, 0.f, 0.f, 0.f};
    const int li = lane & 15;
    LAS char* trb = vbuf + (4 * g + (li >> 2)) * VP + (li & 3) * 8;
    NA_VWRITE(0);
#pragma unroll
    for (int s = 0; s < 8; ++s) {
        if (s + 2 < 8) NA_VLOAD(s + 2);
        u32x4 pw; pw.x = cvtpk(acc[2 * s][0], acc[2 * s][1]); pw.y = cvtpk(acc[2 * s][2], acc[2 * s][3]); pw.z = cvtpk(acc[2 * s + 1][0], acc[2 * s + 1][1]); pw.w = cvtpk(acc[2 * s + 1][2], acc[2 * s + 1][3]);
        const bf16x8 pb = __builtin_bit_cast(bf16x8, pw);
        LAS char* tb = trb + (s & 1) * VBUF;
#pragma unroll
        for (int db = 0; db < 4; ++db) {
            const v4i16_t t0 = __builtin_amdgcn_ds_read_tr16_b64_v4i16((LAS v4i16_t*)(tb + db * 32));
            const v4i16_t t1 = __builtin_amdgcn_ds_read_tr16_b64_v4i16((LAS v4i16_t*)(tb + 16 * VP + db * 32));
            const bf16x8 vf = (bf16x8){t0[0], t0[1], t0[2], t0[3], t1[0], t1[1], t1[2], t1[3]};
            o[db] = __builtin_amdgcn_mfma_f32_16x16x32_bf16(vf, pb, o[db], 0, 0, 0);
        }
        if (s + 1 < 8) NA_VWRITE(s + 1);
    }
    const float rl = __builtin_amdgcn_rcpf(l);
    bf16_t* op = MIX + (size_t)qtok * DM + 512 + h * 64 + 4 * g;
#pragma unroll
    for (int db = 0; db < 4; ++db) { u32x2 w; w.x = cvtpk(o[db][0] * rl, o[db][1] * rl); w.y = cvtpk(o[db][2] * rl, o[db][3] * rl); *(u32x2*)(op + db * 16) = w; }
#undef NA_VLOAD
#undef NA_VWRITE
}

__device__ __forceinline__ float shx(float v, int mask, int lane) { return __builtin_bit_cast(float, __builtin_amdgcn_ds_bpermute((lane ^ mask) << 2, __builtin_bit_cast(int, v))); }
template <int D>
__device__ __forceinline__ void unit2(const bf16_t* __restrict__ Z, bf16_t* __restrict__ MIX, const LAS float* rpb, LAS char* vbuf, int tokbase, int rows, int r0, int j, int h) {
    constexpr int NB = 8 + D;
    const int lane = lane_id_asm();
    const int q = lane & 15, g = lane >> 4;
    const int rs0 = min(max(r0 - 4, 0), rows - 8);
    const int bcs = min(max(16 * j - 8, 0), 32);
    const int qtok = tokbase + r0 * 64 + 16 * j + q;
    bf16x8 qf[2][2];
#pragma unroll
    for (int qr = 0; qr < 2; ++qr) { const bf16_t* qp = Z + (size_t)(qtok + 64 * qr) * ZP + Z_NQ + h * 64 + 8 * g; qf[qr][0] = *(const bf16x8*)qp; qf[qr][1] = *(const bf16x8*)(qp + 32); }
    const bf16_t* vsrc = Z + (size_t)(tokbase + rs0 * 64 + bcs) * ZP + Z_NV + h * 64;
    bf16x8 vr[2][4];
#define NA_VLOAD(s) do { _Pragma("unroll") for (int it = 0; it < 4; ++it) { const int id = it * 64 + lane; vr[(s) & 1][it] = *(const bf16x8*)(vsrc + (size_t)((s) * 64 + (id >> 3)) * ZP + (id & 7) * 8); } } while (0)
#define NA_VWRITE(b) do { _Pragma("unroll") for (int it = 0; it < 4; ++it) { const int id = it * 64 + lane; *(LAS bf16x8*)(vbuf + ((b) & 1) * VBUF + (id >> 3) * VP + (id & 7) * 16) = vr[(b) & 1][it]; } } while (0)
    f32x4 acc[2][16];
    const bf16_t* kbase = Z + (size_t)(tokbase + rs0 * 64 + bcs + q) * ZP + Z_NK + h * 64 + 8 * g;
#pragma unroll
    for (int u = 0; u < NB; ++u)
#pragma unroll
        for (int tp = 0; tp < 2; ++tp) {
            const bf16_t* kp = kbase + (size_t)(u * 64 + 16 * tp) * ZP;
            const bf16x8 k0 = *(const bf16x8*)kp, k1 = *(const bf16x8*)(kp + 32);
            if (u < 8) { f32x4 a = {0.f, 0.f, 0.f, 0.f}; a = __builtin_amdgcn_mfma_f32_16x16x32_bf16(k0, qf[0][0], a, 0, 0, 0); a = __builtin_amdgcn_mfma_f32_16x16x32_bf16(k1, qf[0][1], a, 0, 0, 0); acc[0][2 * u + tp] = a; }
            if (u >= D) { f32x4 a = {0.f, 0.f, 0.f, 0.f}; a = __builtin_amdgcn_mfma_f32_16x16x32_bf16(k0, qf[1][0], a, 0, 0, 0); a = __builtin_amdgcn_mfma_f32_16x16x32_bf16(k1, qf[1][1], a, 0, 0, 0); acc[1][2 * (u >= D ? u - D : 0) + tp] = a; }
            if (tp == 1 && (u & 1)) __builtin_amdgcn_sched_barrier(0);
        }
    const int qcol = 16 * j + q, qs = min(max(qcol - 8, 0), 48);
    float rl[2];
#pragma unroll
    for (int qr = 0; qr < 2; ++qr) {
        float mx = -INFINITY;
#pragma unroll
        for (int t = 0; t < 16; ++t) {
            const int dr = (rs0 + qr * D) + (t >> 1) - (r0 + qr) + 7;
#pragma unroll
            for (int i = 0; i < 4; ++i) {
                const int kcol = bcs + 16 * (t & 1) + 4 * g + i;
                const bool valid = (kcol >= qs) && (kcol < qs + 16);
                const int dc = min(max(kcol - qcol + 15, 0), 30);
                const float s_all = (acc[qr][t][i] * 0.125f + rpb[dr * 31 + dc]) * LOG2E;
                const float sv = valid ? s_all : -INFINITY;
                acc[qr][t][i] = sv; mx = fmaxf(mx, sv);
            }
        }
        mx = fmaxf(mx, shx(mx, 16, lane)); mx = fmaxf(mx, shx(mx, 32, lane));
        float l = 0.f;
#pragma unroll
        for (int t = 0; t < 16; ++t)
#pragma unroll
            for (int i = 0; i < 4; ++i) { const float p = __builtin_amdgcn_exp2f(acc[qr][t][i] - mx); acc[qr][t][i] = p; l += p; }
        l += shx(l, 16, lane); l += shx(l, 32, lane);
        rl[qr] = __builtin_amdgcn_rcpf(l);
    }
    f32x4 o[2][4];
#pragma unroll
    for (int qr = 0; qr < 2; ++qr)
#pragma unroll
        for (int db = 0; db < 4; ++db) o[qr][db] = (f32x4){0.f, 0.f, 0.f, 0.f};
    NA_VLOAD(0); NA_VLOAD(1);
    const int li = lane & 15;
    LAS char* trb = vbuf + (4 * g + (li >> 2)) * VP + (li & 3) * 8;
    NA_VWRITE(0);
#pragma unroll
    for (int u = 0; u < NB; ++u) {
        if (u + 2 < NB) NA_VLOAD(u + 2);
        LAS char* tb = trb + (u & 1) * VBUF;
        bf16x8 pb0 = {}, pb1 = {};
        if (u < 8) { u32x4 pw; pw.x = cvtpk(acc[0][2 * u][0], acc[0][2 * u][1]); pw.y = cvtpk(acc[0][2 * u][2], acc[0][2 * u][3]); pw.z = cvtpk(acc[0][2 * u + 1][0], acc[0][2 * u + 1][1]); pw.w = cvtpk(acc[0][2 * u + 1][2], acc[0][2 * u + 1][3]);
            pb0 = __builtin_bit_cast(bf16x8, pw); }
        if (u >= D) { const int ir = (u >= D) ? u - D : 0;
            u32x4 pw; pw.x = cvtpk(acc[1][2 * ir][0], acc[1][2 * ir][1]); pw.y = cvtpk(acc[1][2 * ir][2], acc[1][2 * ir][3]); pw.z = cvtpk(acc[1][2 * ir + 1][0], acc[1][2 * ir + 1][1]); pw.w = cvtpk(acc[1][2 * ir + 1][2], acc[1][2 * ir + 1][3]);
            pb1 = __builtin_bit_cast(bf16x8, pw); }
#pragma unroll
        for (int db = 0; db < 4; ++db) {
            const v4i16_t t0 = __builtin_amdgcn_ds_read_tr16_b64_v4i16((LAS v4i16_t*)(tb + db * 32));
            const v4i16_t t1 = __builtin_amdgcn_ds_read_tr16_b64_v4i16((LAS v4i16_t*)(tb + 16 * VP + db * 32));
            const bf16x8 vf = (bf16x8){t0[0], t0[1], t0[2], t0[3], t1[0], t1[1], t1[2], t1[3]};
            if (u < 8) o[0][db] = __builtin_amdgcn_mfma_f32_16x16x32_bf16(vf, pb0, o[0][db], 0, 0, 0);
            if (u >= D) o[1][db] = __builtin_amdgcn_mfma_f32_16x16x32_bf16(vf, pb1, o[1][db], 0, 0, 0);
        }
        if (u + 1 < NB) NA_VWRITE(u + 1);
        __builtin_amdgcn_sched_barrier(0);
    }
#pragma unroll
    for (int qr = 0; qr < 2; ++qr) { bf16_t* op = MIX + (size_t)(qtok + 64 * qr) * DM + 512 + h * 64 + 4 * g;
#pragma unroll
        for (int db = 0; db < 4; ++db) { u32x2 w; w.x = cvtpk(o[qr][db][0] * rl[qr], o[qr][db][1] * rl[qr]); w.y = cvtpk(o[qr][db][2] * rl[qr], o[qr][db][3] * rl[qr]); *(u32x2*)(op + db * 16) = w; } }
#undef NA_VLOAD
#undef NA_VWRITE
}
}

#define XB_TMO      128
#define XB_XCNT(j)  (256  + 64 * (j))
#define XB_XSUB(j)  (1280 + 64 * (j))
#define XB_XGEN(j)  (2304 + 64 * (j))
#define XB_TOP      3328
#define XB_TOPGEN   3392
#define XCD_BAR_WORDS 3456
#define XB_SPIN_CAP (1u << 20)
__device__ __forceinline__ unsigned xb_ld(unsigned* p)              { return __hip_atomic_load(p, __ATOMIC_RELAXED, __HIP_MEMORY_SCOPE_AGENT); }
__device__ __forceinline__ unsigned xb_add(unsigned* p, unsigned v) { return __hip_atomic_fetch_add(p, v, __ATOMIC_RELAXED, __HIP_MEMORY_SCOPE_AGENT); }
__device__ __forceinline__ unsigned xb_xcc_id() { return (unsigned)__builtin_amdgcn_s_getreg((3 << 11) | 20) & 0xFu; }
#define XB_SPIN(cond, bar) do { unsigned _sp = 0; while (cond) { __builtin_amdgcn_s_sleep(1); \
    if ((++_sp & 255u) == 0u) { if (xb_ld(&(bar)[XB_TMO])) break; if (_sp > XB_SPIN_CAP) { atomicAdd(&(bar)[XB_TMO], 1u); break; } } } } while (0)
struct XcdBarrier { unsigned* bar; unsigned x; volatile LAS unsigned* st; };
__device__ __forceinline__ XcdBarrier xcd_barrier_post(unsigned* bar, volatile LAS unsigned* st) {
    XcdBarrier b; b.bar = bar; b.x = xb_xcc_id(); b.st = st;
    if (threadIdx.x == 0) (void)xb_add(&bar[XB_XCNT(b.x)], 1u);
    return b;
}
__device__ __forceinline__ void xcd_barrier_complete(unsigned* bar, unsigned x, unsigned& nloc, unsigned& nx) {
    const unsigned G = gridDim.x * gridDim.y * gridDim.z;
    unsigned sum, cnt, mine, sp = 0u;
    for (;;) {
        sum = 0u; cnt = 0u; mine = 0u;
#pragma unroll
        for (unsigned j = 0; j < 16; ++j) { const unsigned c = xb_ld(&bar[XB_XCNT(j)]); sum += c; cnt += (c > 0u) ? 1u : 0u; mine = (j == x) ? c : mine; }
        if (sum == G) break;
        __builtin_amdgcn_s_sleep(1);
        if ((++sp & 255u) == 0u) { if (xb_ld(&bar[XB_TMO])) break; if (sp > XB_SPIN_CAP) { atomicAdd(&bar[XB_TMO], 1u); break; } }
    }
    nloc = mine > 0u ? mine : 1u; nx = cnt > 0u ? cnt : 1u;
}
__device__ __forceinline__ void xcd_barrier(const XcdBarrier& b) {
    asm volatile("s_waitcnt vmcnt(0)" ::: "memory");
    __syncthreads();
    if (threadIdx.x == 0) {
        unsigned* bar = b.bar;
        __builtin_amdgcn_s_waitcnt(0);
        unsigned nloc = b.st[0], nx = b.st[1];
        if (nloc == 0u) { xcd_barrier_complete(bar, b.x, nloc, nx); b.st[0] = nloc; b.st[1] = nx; }
        const unsigned old = xb_add(&bar[XB_XSUB(b.x)], 1u);
        const unsigned gen = old / nloc;
        if (old + 1u == (gen + 1u) * nloc) {
            __builtin_amdgcn_fence(__ATOMIC_RELEASE, "agent");
            asm volatile("s_waitcnt vmcnt(0)" ::: "memory");
            const unsigned og = xb_add(&bar[XB_TOP], 1u);
            const unsigned tg = og / nx;
            if (og + 1u == (tg + 1u) * nx) xb_add(&bar[XB_TOPGEN], 1u);
            else XB_SPIN(xb_ld(&bar[XB_TOPGEN]) == tg, bar);
            __builtin_amdgcn_fence(__ATOMIC_ACQUIRE, "agent");
            xb_add(&bar[XB_XGEN(b.x)], 1u);
            asm volatile("s_waitcnt vmcnt(0)" ::: "memory");
        } else {
            XB_SPIN(xb_ld(&bar[XB_XGEN(b.x)]) == gen, bar);
            __builtin_amdgcn_fence(__ATOMIC_ACQUIRE, "agent");
            asm volatile("s_waitcnt vmcnt(0)" ::: "memory");
        }
    }
    __syncthreads();
}

struct Params {
    const float* x_prompt; const float* x_sample; const float* g_mix_pre; const float* w_in; const float* g_q_lat; const float* w_q_up;
    const float* g_kv_lat; const float* w_kv_up; const float* na_rpb; const float* w_o; const float* g_mix_post; const float* g_ffn_pre;
    const float* w_ffn_up; const float* ffn_conv_w; const float* ffn_conv_b; const float* w_ffn_down; const float* g_ffn_post;
    float* out; unsigned char* ws;
};
constexpr int LDS_XCH = pg8::STAGE_BYTES + 1024, LDS_TOTAL = LDS_XCH + 8192;

__device__ __forceinline__ const float* xrow(const float* xp, const float* xs, int t) { return t < MP ? xp + (size_t)t * DM : xs + (size_t)(t - MP) * DM; }

__device__ __forceinline__ int srccol(int mode, int n) {
    if (mode == 0) {
        if (n < Z_KR) return n;
        if (n < Z_KR + 32) { const int jj = n - Z_KR; return Z_KR + (jj >> 1) + 16 * (jj & 1); }
        return n < ZP ? n : -1;
    } else if (mode == 1) {
        const int h = n / 96, d = n % 96;
        if (d < 64) return h * 96 + d;
        const int jj = d - 64; return h * 96 + 64 + (jj >> 1) + 16 * (jj & 1);
    } else if (mode == 2) {
        if (n < 512) return (n >> 6) * 128 + (n & 63);
        const int m2 = n - 512; return (m2 >> 6) * 128 + 64 + (m2 & 63);
    }
    if (mode == 4) { const int tile = n >> 8, w = n & 255; return (w < 128) ? (tile * 128 + w) : (DFF + tile * 128 + (w - 128)); }
    return n;
}
__device__ __forceinline__ void transpose_item(const float* __restrict__ W, int K, int Nsrc, bf16_t* __restrict__ WT, int Ndst, const float* __restrict__ kscale, int mode,
                                               LAS float* scr, int it, int lane) {
    const int nblk = Ndst / 32;
    {
        const int kb = it / nblk, nb = it % nblk, k0 = 64 * kb, n0 = 32 * nb;
        const int sc = srccol(mode, n0 + (lane & 31));
        float tv[32];
#pragma unroll
        for (int i = 0; i < 32; ++i) { const int kk = 2 * i + (lane >> 5); tv[i] = (sc >= 0) ? W[(size_t)(k0 + kk) * Nsrc + sc] : 0.f; }
        if (kscale) {
#pragma unroll
            for (int i = 0; i < 32; ++i) tv[i] *= kscale[k0 + 2 * i + (lane >> 5)]; }
#pragma unroll
        for (int i = 0; i < 32; ++i) scr[(2 * i + (lane >> 5)) * 33 + (lane & 31)] = tv[i];
        asm volatile("s_waitcnt lgkmcnt(0)" ::: "memory");
        const int c = lane & 7;
#pragma unroll
        for (int jx = 0; jx < 4; ++jx) { const int n = (lane >> 3) + 8 * jx; const LAS float* s = scr + (8 * c) * 33 + n;
            u32x4 o; o.x = cvtpk(s[0 * 33], s[1 * 33]); o.y = cvtpk(s[2 * 33], s[3 * 33]); o.z = cvtpk(s[4 * 33], s[5 * 33]); o.w = cvtpk(s[6 * 33], s[7 * 33]);
            *(u32x4*)(WT + (size_t)(n0 + n) * K + k0 + 8 * c) = o; }
        asm volatile("s_waitcnt lgkmcnt(0)" ::: "memory");
    }
}

__device__ const double ROPE_INV[16] = {1.0, 0.5623413251903491, 0.31622776601683794, 0.1778279410038923, 0.1, 0.05623413251903491, 0.031622776601683794, 0.01778279410038923,
                                        0.01, 0.005623413251903491, 0.0031622776601683794, 0.001778279410038923, 0.001, 0.0005623413251903491, 0.00031622776601683794, 0.0001778279410038923};


typedef const __attribute__((address_space(4))) Params* CParams;
__device__ __forceinline__ CParams kparams() { CParams q = (CParams)__builtin_amdgcn_kernarg_segment_ptr(); asm volatile("" : "+s"(q)); return q; }
__global__ void __launch_bounds__(512) fwd_kernel(Params p_unused) {
    extern __shared__ __attribute__((aligned(16))) unsigned char lds_raw[];
    LAS unsigned char* lds = (LAS unsigned char*)lds_raw;
    cg::grid_group grid = cg::this_grid();
    const int wave = __builtin_amdgcn_readfirstlane(threadIdx.x >> 6);
#define FRESH_TID() const int lane = lane_id_asm(), tid = wave * 64 + lane; (void)tid
    const int G = gridDim.x, bid = blockIdx.x;
    const int vcu = (G % 8 == 0) ? (bid % 8) * (G / 8) + bid / 8 : bid;
    const int gw = vcu * 8 + wave, NGW = G * 8;
#define PHASE_PTRS() const CParams pp = kparams(); unsigned char* const ws = pp->ws; (void)ws
#define Win_t ((bf16_t*)(ws + WS_WIN))
#define Wq_t ((bf16_t*)(ws + WS_WQ))
#define Wkv_t ((bf16_t*)(ws + WS_WKV))
#define Wo_t ((bf16_t*)(ws + WS_WO))
#define Wup_t ((bf16_t*)(ws + WS_WUP))
#define Wdn_t ((bf16_t*)(ws + WS_WDN))
#define cosT ((float*)(ws + WS_COS))
#define sinT ((float*)(ws + WS_SIN))
#define rstd_q ((float*)(ws + WS_RSQ))
#define rstd_kv ((float*)(ws + WS_RSKV))
#define R1 ((bf16_t*)(ws + WS_R1))
#define Z ((bf16_t*)(ws + WS_Z))
#define Qb ((bf16_t*)(ws + WS_Q))
#define Kb ((bf16_t*)(ws + WS_K))
#define Vb ((bf16_t*)(ws + WS_V))
#define MO ((bf16_t*)(ws + WS_MO))
#define ACT ((bf16_t*)(ws + WS_ACT))

    volatile LAS unsigned* bst = (volatile LAS unsigned*)(lds + pg8::STAGE_BYTES);
    {
        FRESH_TID(); PHASE_PTRS(); const float* xp_ = pp->x_prompt; const float* xs_ = pp->x_sample;
        if (tid < 2) bst[tid] = 0u;
        if (bid == 0) for (int i = tid; i < XCD_BAR_WORDS; i += 512) ((unsigned*)ws)[i] = 0u;
        LAS float* scr = (LAS float*)(lds + wave * 16384);
        {
            constexpr int I0 = 16 * 64, I1 = 4 * 24, I2 = 2 * 32, I3 = 16 * 32, I4 = 16 * 176, I5 = 44 * 32;
            for (int it = gw; it < I0 + I1 + I2 + I3 + I4 + I5; it += NGW) {
                int r = it;
                if (r < I0) { transpose_item(pp->w_in, 1024, 1952, Win_t, 2048, nullptr, 0, scr, r, lane); continue; } r -= I0;
                if (r < I1) { transpose_item(pp->w_q_up, 256, 768, Wq_t, 768, pp->g_q_lat, 1, scr, r, lane); continue; } r -= I1;
                if (r < I2) { transpose_item(pp->w_kv_up, 128, 1024, Wkv_t, 1024, pp->g_kv_lat, 2, scr, r, lane); continue; } r -= I2;
                if (r < I3) { transpose_item(pp->w_o, 1024, 1024, Wo_t, 1024, nullptr, 3, scr, r, lane); continue; } r -= I3;
                if (r < I4) { transpose_item(pp->w_ffn_up, 1024, NUP, Wup_t, NUP, nullptr, 4, scr, r, lane); continue; } r -= I4;
                transpose_item(pp->w_ffn_down, DFF, 1024, Wdn_t, 1024, nullptr, 3, scr, r, lane);
            }
        }
        for (int e = bid * 512 + tid; e < M; e += G * 512) { rstd_q[e] = 0.f; rstd_kv[e] = 0.f; }
        for (int e = bid * 512 + tid; e < SP * 16; e += G * 512) {
            const int s = e >> 4, i = e & 15;
            const double rev = (double)s * ROPE_INV[i] * 0.15915494309189535;
            const float fr = (float)(rev - floor(rev));
            cosT[e] = __builtin_amdgcn_cosf(fr); sinT[e] = __builtin_amdgcn_sinf(fr);
        }
        for (int t = gw; t < M; t += 2 * NGW) {
            f32x4 v[2][4]; float ss[2];
#pragma unroll
            for (int r = 0; r < 2; ++r) { const float* xr = xrow(xp_, xs_, t + r * NGW); ss[r] = 0.f;
#pragma unroll
                for (int j = 0; j < 4; ++j) v[r][j] = *(const f32x4*)(xr + 256 * j + 4 * lane); }
#pragma unroll
            for (int r = 0; r < 2; ++r) {
#pragma unroll
                for (int j = 0; j < 4; ++j) ss[r] += (v[r][j].x * v[r][j].x + v[r][j].y * v[r][j].y) + (v[r][j].z * v[r][j].z + v[r][j].w * v[r][j].w);
                const float rstd = rsqrtf(wave_sum(ss[r]) * (1.f / DM) + EPS);
#pragma unroll
                for (int j = 0; j < 4; ++j) { const f32x4 gg = *(const f32x4*)(pp->g_mix_pre + 256 * j + 4 * lane); const f32x4 o = v[r][j] * rstd * gg;
                    u32x2 w; w.x = cvtpk(o.x, o.y); w.y = cvtpk(o.z, o.w); *(u32x2*)(R1 + (size_t)(t + r * NGW) * DM + 256 * j + 4 * lane) = w; } }
        }
    }
    grid.sync();
    { PHASE_PTRS(); (void)xcd_barrier_post((unsigned*)ws, bst); }
#define GRID_BAR() do { XcdBarrier xb_; xb_.bar = (unsigned*)kparams()->ws; xb_.x = xb_xcc_id(); xb_.st = (volatile LAS unsigned*)(lds + pg8::STAGE_BYTES); xcd_barrier(xb_); } while (0)

    {
        PHASE_PTRS(); pg8::Gemm g{R1, Win_t, M, ZW, 1024, 1024, 1024}; pg8::StaticOrder S; S.init(M, ZW, G, bid);
        pg8::EpiZ E{Z, ZP, rstd_q, rstd_kv, Kb, cosT, sinT};
        pg8::gemm_phase(lds, g, S, E, wave);
    }
    GRID_BAR();
    {
        PHASE_PTRS(); pg8::Gemm g{Z, Wq_t, M, QW, 256, ZP, 256}; pg8::StaticOrder S; S.init(M, QW, G, bid);
        pg8::EpiQ E{Qb, rstd_q, cosT, sinT};
        pg8::gemm_phase(lds, g, S, E, wave);
    }
    {
        PHASE_PTRS(); pg8::Gemm g{Z + Z_CKV, Wkv_t, M, 1024, 128, ZP, 128}; pg8::StaticOrder S; S.init(M, 1024, G, bid);
        pg8::EpiKV E{Kb, Vb, rstd_kv};
        pg8::gemm_phase(lds, g, S, E, wave);
    }
    GRID_BAR();
    {
        FRESH_TID(); PHASE_PTRS();
        for (int it = 0;; ++it) {
            const int slot = it * G + vcu; if (slot >= 1536) break;
            int tokbase, h, qb, seq;
            if (slot < 1024) { const int i = slot >> 8, v = slot & 255, x = v >> 5, c = v & 31; const int pair = 2 * x + (i >> 1); tokbase = (pair >> 3) * SP; h = pair & 7; qb = (i & 1) * 32 + c; seq = SP; }
            else { const int s2 = slot - 1024, i = s2 >> 8, v = s2 & 255, x = v >> 5, c = v & 31; const int u = i * 32 + c, bh = 8 * x + (u >> 3); tokbase = MP + (bh >> 3) * SS; h = bh & 7; qb = u & 7; seq = SS; }
            mla2::attn_unit(Qb + (size_t)(tokbase + qb * 256) * QW + h * 96, Kb + (size_t)(h * NGT + (tokbase >> 6)) * 6144, Vb + (size_t)(h * NGT + (tokbase >> 6)) * 4096,
                           R1 + (size_t)(tokbase + qb * 256) * DM + h * 64, seq, (LAS char*)lds, wave);
        }
        LAS float* rpbl = (LAS float*)(lds + na::LDS_RPB);
        for (int i = tid; i < 8 * 465; i += 512) rpbl[i] = pp->na_rpb[i];
        __syncthreads();
        const int per = (1536 + G - 1) / G;
        LAS char* vbuf = (LAS char*)(lds + na::LDS_VB + wave * 2 * na::VBUF);
        for (int u = vcu * per; u < min(1536, (vcu + 1) * per); ++u) {
            const int grow = (u >> 2) * 2, j = u & 3; int tokbase, rows, r0;
            if (grow < 512) { tokbase = (grow >> 8) * SP; r0 = grow & 255; rows = 256; } else { const int g2 = grow - 512; tokbase = MP + (g2 >> 5) * SS; r0 = g2 & 31; rows = 32; }
            const int rs0 = min(max(r0 - 4, 0), rows - 8), rs1 = min(max(r0 - 3, 0), rows - 8);
            if (rs1 != rs0) na::unit2<1>(Z, R1, rpbl + wave * 465, vbuf, tokbase, rows, r0, j, wave);
            else na::unit2<0>(Z, R1, rpbl + wave * 465, vbuf, tokbase, rows, r0, j, wave);
        }
        __syncthreads();
    }
    GRID_BAR();
    {
        PHASE_PTRS(); pg8::Gemm g{R1, Wo_t, M, 1024, 1024, 1024, 1024}; pg8::StaticOrder S; S.init(M, 1024, G, bid);
        pg8::EpiStore E{MO, MOP};
        pg8::gemm_phase(lds, g, S, E, wave);
    }
    GRID_BAR();
    { FRESH_TID(); PHASE_PTRS(); const float* xp_ = pp->x_prompt; const float* xs_ = pp->x_sample;
    for (int t = gw; t < M; t += 2 * NGW) {
        f32x4 v[2][4], xv[2][4];
#pragma unroll
        for (int r = 0; r < 2; ++r) { const int tr = t + r * NGW; const float* xr = xrow(xp_, xs_, tr);
#pragma unroll
            for (int j = 0; j < 4; ++j) { const u32x2 w = *(const u32x2*)(MO + (size_t)tr * MOP + 256 * j + 4 * lane); v[r][j] = (f32x4){bflo(w.x), bfhi(w.x), bflo(w.y), bfhi(w.y)};
                xv[r][j] = *(const f32x4*)(xr + 256 * j + 4 * lane); } }
#pragma unroll
        for (int r = 0; r < 2; ++r) { const int tr = t + r * NGW; float ss = 0.f;
#pragma unroll
            for (int j = 0; j < 4; ++j) ss += (v[r][j].x * v[r][j].x + v[r][j].y * v[r][j].y) + (v[r][j].z * v[r][j].z + v[r][j].w * v[r][j].w);
            const float rstd = rsqrtf(wave_sum(ss) * (1.f / DM) + EPS);
            float s2 = 0.f;
#pragma unroll
            for (int j = 0; j < 4; ++j) { const f32x4 gg = *(const f32x4*)(pp->g_mix_post + 256 * j + 4 * lane);
                v[r][j] = xv[r][j] + v[r][j] * rstd * gg; s2 += (v[r][j].x * v[r][j].x + v[r][j].y * v[r][j].y) + (v[r][j].z * v[r][j].z + v[r][j].w * v[r][j].w);
                *(f32x4*)(pp->out + (size_t)tr * DM + 256 * j + 4 * lane) = v[r][j]; }
            const float rstd2 = rsqrtf(wave_sum(s2) * (1.f / DM) + EPS);
#pragma unroll
            for (int j = 0; j < 4; ++j) { const f32x4 gg = *(const f32x4*)(pp->g_ffn_pre + 256 * j + 4 * lane); const f32x4 o = v[r][j] * rstd2 * gg;
                u32x2 w; w.x = cvtpk(o.x, o.y); w.y = cvtpk(o.z, o.w); *(u32x2*)(R1 + (size_t)tr * DM + 256 * j + 4 * lane) = w; } }
    } }
    GRID_BAR();
    {
        PHASE_PTRS(); pg8::Gemm g{R1, Wup_t, M, NUP, 1024, 1024, 1024}; pg8::StaticOrder S; S.init_tiles(pg8::OVL_NM, NUP / 256, G, bid);
        pg8::EpiConv E{ACT, pp->ffn_conv_w, pp->ffn_conv_b, (LAS float*)(lds + LDS_XCH)};
        pg8::gemm_phase<pg8::EpiConv, true>(lds, g, S, E, wave);
    }
    GRID_BAR();
    {
        PHASE_PTRS(); pg8::Gemm g{ACT, Wdn_t, M, 1024, DFF, DFF, DFF}; pg8::StaticOrder S; S.init(M, 1024, G, bid);
        pg8::EpiStore E{MO, MOP};
        pg8::gemm_phase(lds, g, S, E, wave);
    }
    GRID_BAR();
    { FRESH_TID(); PHASE_PTRS();
    for (int t = gw; t < M; t += 2 * NGW) {
        f32x4 v[2][4], xv[2][4];
#pragma unroll
        for (int r = 0; r < 2; ++r) { const int tr = t + r * NGW;
#pragma unroll
            for (int j = 0; j < 4; ++j) { const u32x2 w = *(const u32x2*)(MO + (size_t)tr * MOP + 256 * j + 4 * lane); v[r][j] = (f32x4){bflo(w.x), bfhi(w.x), bflo(w.y), bfhi(w.y)};
                xv[r][j] = *(const f32x4*)(pp->out + (size_t)tr * DM + 256 * j + 4 * lane); } }
#pragma unroll
        for (int r = 0; r < 2; ++r) { const int tr = t + r * NGW; float ss = 0.f;
#pragma unroll
            for (int j = 0; j < 4; ++j) ss += (v[r][j].x * v[r][j].x + v[r][j].y * v[r][j].y) + (v[r][j].z * v[r][j].z + v[r][j].w * v[r][j].w);
            const float rstd = rsqrtf(wave_sum(ss) * (1.f / DM) + EPS);
#pragma unroll
            for (int j = 0; j < 4; ++j) { const f32x4 gg = *(const f32x4*)(pp->g_ffn_post + 256 * j + 4 * lane);
                *(f32x4*)(pp->out + (size_t)tr * DM + 256 * j + 4 * lane) = xv[r][j] + v[r][j] * rstd * gg; } }
    } }
}

extern "C" void kernel_launch(void* const* d_in, const int* in_sizes, int n_in, void* d_out, int out_size, void* d_ws, size_t ws_size, hipStream_t stream) {
    static int grid_blocks = 0;
    if (grid_blocks == 0) {
        if (n_in != 17 || in_sizes[0] != MP * DM || in_sizes[1] != MS * DM || out_size != M * DM || ws_size < WS_END) {
            fprintf(stderr, "kernel_launch: unexpected shapes (n_in %d, in0 %d, in1 %d, out %d, ws %zu)\n", n_in, n_in > 0 ? in_sizes[0] : -1, n_in > 1 ? in_sizes[1] : -1, out_size, ws_size);
            grid_blocks = -1; return; }
        int dev = 0, cus = 0, per_cu = 0;
        hipGetDevice(&dev);
        hipDeviceGetAttribute(&cus, hipDeviceAttributeMultiprocessorCount, dev);
        hipFuncSetAttribute((const void*)fwd_kernel, hipFuncAttributeMaxDynamicSharedMemorySize, LDS_TOTAL);
        hipOccupancyMaxActiveBlocksPerMultiprocessor(&per_cu, (const void*)fwd_kernel, 512, LDS_TOTAL);
        if (per_cu < 1) { fprintf(stderr, "kernel_launch: occupancy query returned %d\n", per_cu); per_cu = 1; }
        (void)hipGetLastError();
        grid_blocks = cus * 1;
    }
    if (grid_blocks < 0) return;
    Params p{};
    p.x_prompt = (const float*)d_in[0]; p.x_sample = (const float*)d_in[1]; p.g_mix_pre = (const float*)d_in[2]; p.w_in = (const float*)d_in[3];
    p.g_q_lat = (const float*)d_in[4]; p.w_q_up = (const float*)d_in[5]; p.g_kv_lat = (const float*)d_in[6]; p.w_kv_up = (const float*)d_in[7];
    p.na_rpb = (const float*)d_in[8]; p.w_o = (const float*)d_in[9]; p.g_mix_post = (const float*)d_in[10]; p.g_ffn_pre = (const float*)d_in[11];
    p.w_ffn_up = (const float*)d_in[12]; p.ffn_conv_w = (const float*)d_in[13]; p.ffn_conv_b = (const float*)d_in[14]; p.w_ffn_down = (const float*)d_in[15];
    p.g_ffn_post = (const float*)d_in[16]; p.out = (float*)d_out; p.ws = (unsigned char*)d_ws;
    void* args[] = {&p};
    hipError_t e = hipLaunchCooperativeKernel((const void*)fwd_kernel, dim3(grid_blocks), dim3(512), args, LDS_TOTAL, stream);
    if (e != hipSuccess) fprintf(stderr, "cooperative launch failed: %s (grid %d)\n", hipGetErrorString(e), grid_blocks);
}
```

```cpp
#include <hip/hip_runtime.h>
#include <hip/hip_cooperative_groups.h>
#include <cstdio>
#include <cstdint>
namespace cg = cooperative_groups;

#define LAS __attribute__((address_space(3)))
typedef unsigned short bf16_t;
typedef short bf16x8 __attribute__((ext_vector_type(8)));
typedef short s16x4 __attribute__((ext_vector_type(4)));
typedef float f32x2 __attribute__((ext_vector_type(2)));
typedef float f32x4 __attribute__((ext_vector_type(4)));
typedef float f32x16 __attribute__((ext_vector_type(16)));
typedef unsigned u32x2 __attribute__((ext_vector_type(2)));
typedef unsigned u32x4 __attribute__((ext_vector_type(4)));
typedef __bf16 bf16x2_t __attribute__((ext_vector_type(2)));

constexpr int MP = 32768, MS = 16384, M = MP + MS;
constexpr int DM = 1024, ZW = 2048, DFF = 2816, NUP = 2 * DFF;
constexpr int SP = 16384, SS = 2048;
constexpr int QW = 768, NGT = M / 64;
constexpr float EPS = 1e-6f;
constexpr float LOG2E = 1.4426950408889634f;
constexpr float QSCALE = 0.10206207261596575f * LOG2E;
constexpr int Z_CKV = 256, Z_KR = 384, Z_NQ = 416, Z_NK = 928, Z_NV = 1440;
constexpr int ZP = 1952;
constexpr int MOP = 1056;

constexpr size_t MiB = 1u << 20;
constexpr size_t WS_WIN = 1 * MiB;
constexpr size_t WS_WQ = 5 * MiB;
constexpr size_t WS_WKV = 5 * MiB + 512 * 1024;
constexpr size_t WS_WO = 6 * MiB;
constexpr size_t WS_WUP = 8 * MiB;
constexpr size_t WS_WDN = 19 * MiB;
constexpr size_t WS_COS = 25 * MiB, WS_SIN = 26 * MiB;
constexpr size_t WS_RSQ = 27 * MiB, WS_RSKV = 27 * MiB + 256 * 1024;
constexpr size_t WS_R1 = 32 * MiB;
constexpr size_t WS_Z = 128 * MiB;
constexpr size_t WS_Q = 320 * MiB, WS_K = 392 * MiB, WS_V = 464 * MiB;
constexpr size_t WS_MO = 128 * MiB;
constexpr size_t WS_ACT = 228 * MiB;
constexpr size_t WS_END = 512 * MiB;

__device__ __forceinline__ unsigned cvtpk(float lo, float hi) { f32x2 v = {lo, hi}; bf16x2_t b = __builtin_convertvector(v, bf16x2_t); return __builtin_bit_cast(unsigned, b); }
__device__ __forceinline__ float bflo(unsigned w) { return __uint_as_float(w << 16); }
__device__ __forceinline__ float bfhi(unsigned w) { return __uint_as_float(w & 0xffff0000u); }
__device__ __forceinline__ float wave_sum(float v) {
#pragma unroll
    for (int o = 1; o < 64; o <<= 1) v += __shfl_xor(v, o);
    return v;
}
__device__ __forceinline__ int lane_id_asm() { int l; asm volatile("v_mbcnt_lo_u32_b32 %0, -1, 0\n\tv_mbcnt_hi_u32_b32 %0, -1, %0" : "=v"(l)); return l; }
__device__ __forceinline__ int seqpos(int t) { return t < MP ? (t & (SP - 1)) : (t & (SS - 1)); }

__device__ __forceinline__ float gelu_tanh(float g) {
    const float u = g + 0.044715f * g * g * g;
    return g * __builtin_amdgcn_rcpf(1.f + __builtin_amdgcn_exp2f(-2.3022081983f * u));
}
__device__ __forceinline__ float dpp_prev(float v) { return __builtin_bit_cast(float, __builtin_amdgcn_mov_dpp(__builtin_bit_cast(int, v), 0x121, 0xF, 0xF, true)); }
__device__ __forceinline__ float dpp_next(float v) { return __builtin_bit_cast(float, __builtin_amdgcn_mov_dpp(__builtin_bit_cast(int, v), 0x12F, 0xF, 0xF, true)); }

template <bool EDGE> __device__ __forceinline__ void conv_col(float x0, float x1, float x2, float x3, float top, float bot, bool f0, bool f15, int sqb, int S,
                                         float w0, float w1, float w2, float b, float& h0, float& h1, float& h2, float& h3) {
    asm volatile("" : "+v"(x0), "+v"(x1), "+v"(x2), "+v"(x3));
    const float p0 = dpp_prev(x0), p1 = dpp_prev(x1), p2 = dpp_prev(x2), p3 = dpp_prev(x3);
    const float n0 = dpp_next(x0), n1 = dpp_next(x1), n2 = dpp_next(x2), n3 = dpp_next(x3);
    float u0 = f0 ? top : p0, u1 = f0 ? p0 : p1, u2 = f0 ? p1 : p2, u3 = f0 ? p2 : p3;
    float d0 = f15 ? n1 : n0, d1 = f15 ? n2 : n1, d2 = f15 ? n3 : n2, d3 = f15 ? bot : n3;
    if (EDGE) {
    const int sm = S - 1;
    u0 = ((sqb & sm) == 0) ? 0.f : u0; u1 = (((sqb + 16) & sm) == 0) ? 0.f : u1; u2 = (((sqb + 32) & sm) == 0) ? 0.f : u2; u3 = (((sqb + 48) & sm) == 0) ? 0.f : u3;
    d0 = ((sqb & sm) == sm) ? 0.f : d0; d1 = (((sqb + 16) & sm) == sm) ? 0.f : d1; d2 = (((sqb + 32) & sm) == sm) ? 0.f : d2; d3 = (((sqb + 48) & sm) == sm) ? 0.f : d3;
    }
    h0 = b + w0 * u0 + w1 * x0 + w2 * d0; h1 = b + w0 * u1 + w1 * x1 + w2 * d1; h2 = b + w0 * u2 + w1 * x2 + w2 * d2; h3 = b + w0 * u3 + w1 * x3 + w2 * d3;
}

template <bool EDGE> __device__ __forceinline__ void conv_rows(float x0, float x1, float x2, float x3, float top, float bot, bool f0, bool f15, int sqb, int S,
                                                          float w0, float w1, float w2, float b, float& h0, float& h1, float& h2, float& h3) {
    asm volatile("" : "+v"(x0), "+v"(x1), "+v"(x2), "+v"(x3));
    const float p3 = dpp_prev(x3), n0 = dpp_next(x0);
    float u0 = f0 ? top : p3, u1 = x0, u2 = x1, u3 = x2;
    float d0 = x1, d1 = x2, d2 = x3, d3 = f15 ? bot : n0;
    if (EDGE) {
        const int sm = S - 1;
        u0 = ((sqb & sm) == 0) ? 0.f : u0; u1 = (((sqb + 1) & sm) == 0) ? 0.f : u1; u2 = (((sqb + 2) & sm) == 0) ? 0.f : u2; u3 = (((sqb + 3) & sm) == 0) ? 0.f : u3;
        d0 = ((sqb & sm) == sm) ? 0.f : d0; d1 = (((sqb + 1) & sm) == sm) ? 0.f : d1; d2 = (((sqb + 2) & sm) == sm) ? 0.f : d2; d3 = (((sqb + 3) & sm) == sm) ? 0.f : d3;
    }
    h0 = b + w0 * u0 + w1 * x0 + w2 * d0; h1 = b + w0 * u1 + w1 * x1 + w2 * d1; h2 = b + w0 * u2 + w1 * x2 + w2 * d2; h3 = b + w0 * u3 + w1 * x3 + w2 * d3;
}

namespace pg8 {
constexpr int BM = 256, BK = 64, HALF = 128, HTB = HALF * BK * 2, STAGE_BYTES = 8 * HTB, NXCD = 8, WGM = 8;
__device__ __forceinline__ int lds_byte(int r, int c) { const int st = (r >> 4) * 2 + (c >> 5), rr = r & 15, cc = c & 31, ob = rr * 64 + cc * 2; return st * 1024 + (ob ^ (((ob >> 9) & 1) << 5)); }
__device__ __forceinline__ void stage_rc(int b, int& R, int& C) { const int st = b / 1024, sb = b % 1024, swz = sb ^ (((sb >> 9) & 1) << 5); R = (st >> 1) * 16 + swz / 64; C = (st & 1) * 32 + (swz % 64) / 2; }
__device__ __forceinline__ int perm32(int rho) { const int n = rho >> 4, i = rho & 15; return 8 * (i >> 2) + 4 * n + (i & 3); }
struct Unit { int pm, pn; };
constexpr int OVL_TP = 65, OVL_NM = 3 * OVL_TP;
__device__ __forceinline__ void ovl_decode(int pm, int& regbase, int& t, int& S) {
    const int q = pm / OVL_TP; regbase = q * SP; t = pm - OVL_TP * q; S = (q < 2) ? SP : SS;
}
template <bool OVL> __device__ __forceinline__ long tile_row0(int pm) {
    if (!OVL) return (long)pm * 256;
    int seqbase, t, S; ovl_decode(pm, seqbase, t, S); return (long)seqbase + 254 * t - 1;
}
struct Gemm { const bf16_t* A; const bf16_t* Bt; int M, N, K, lda, ldb; };
struct StaticOrder {
    int nM, nN, nwg, G, c;
    __device__ void init(int M_, int N_, int G_, int c_) { nM = M_ / BM; nN = N_ / BM; nwg = nM * nN; G = G_; c = c_; }
    __device__ void init_tiles(int nM_, int nN_, int G_, int c_) { nM = nM_; nN = nN_; nwg = nM * nN; G = G_; c = c_; }
    __device__ bool next(int i, Unit& u) const {
        const long L = (long)i * G + c; if (L >= nwg) return false;
        int wgid = (int)L; { const int q = nwg / NXCD, r = nwg % NXCD, xcd = wgid % NXCD, off = wgid / NXCD; wgid = (xcd < r ? xcd * (q + 1) : r * (q + 1) + (xcd - r) * q) + off; }
        const int nig = WGM * nN, gid = wgid / nig, fm = gid * WGM, gsz = (nM - fm) < WGM ? (nM - fm) : WGM;
        u.pm = fm + ((wgid % nig) % gsz); u.pn = (wgid % nig) / gsz; return true;
    }
};
typedef f32x4 Acc[2][2][4][2];

struct EpiStore {
    bf16_t* O; int ldc;
    __device__ __forceinline__ void operator()(const Acc& acc, const Unit& u, int wr, int wc, int fr, int fq) const {
        const int row0 = u.pm * BM + wr * 64 + fr, col0 = u.pn * BM + wc * 32 + 8 * fq;
#pragma unroll
        for (int ai = 0; ai < 2; ++ai)
#pragma unroll
            for (int m = 0; m < 4; ++m) { bf16_t* rowp = O + (size_t)(row0 + ai * HALF + m * 16) * ldc + col0;
#pragma unroll
                for (int bj = 0; bj < 2; ++bj) { const f32x4 v0 = acc[ai][bj][m][0], v1 = acc[ai][bj][m][1];
                    u32x4 w; w.x = cvtpk(v0[0], v0[1]); w.y = cvtpk(v0[2], v0[3]); w.z = cvtpk(v1[0], v1[1]); w.w = cvtpk(v1[2], v1[3]);
                    *(u32x4*)(rowp + bj * HALF) = w; } }
    }
};
struct EpiZ {
    bf16_t* O; int ldc; float* ssq_q; float* ssq_kv; bf16_t* Kt; const float* cosT; const float* sinT;
    __device__ __forceinline__ void operator()(const Acc& acc, const Unit& u, int wr, int wc, int fr, int fq) const {
        const int row0 = u.pm * BM + wr * 64 + fr, col0 = u.pn * BM + wc * 32 + 8 * fq;
#pragma unroll
        for (int ai = 0; ai < 2; ++ai)
#pragma unroll
            for (int m = 0; m < 4; ++m) { const int row = row0 + ai * HALF + m * 16; bf16_t* rowp = O + (size_t)row * ldc + col0;
#pragma unroll
                for (int bj = 0; bj < 2; ++bj) { const f32x4 v0 = acc[ai][bj][m][0], v1 = acc[ai][bj][m][1];
                    u32x4 w; w.x = cvtpk(v0[0], v0[1]); w.y = cvtpk(v0[2], v0[3]); w.z = cvtpk(v1[0], v1[1]); w.w = cvtpk(v1[2], v1[3]);
                    if (col0 + bj * HALF < ZP) *(u32x4*)(rowp + bj * HALF) = w; }
                if (u.pn <= 1) {
                    float sq = 0.f;
#pragma unroll
                    for (int bj = 0; bj < 2; ++bj) { if (bj == 1 && u.pn == 1) continue;
#pragma unroll
                        for (int n = 0; n < 2; ++n) { const f32x4 v = acc[ai][bj][m][n]; sq += (v[0] * v[0] + v[1] * v[1]) + (v[2] * v[2] + v[3] * v[3]); } }
                    sq += __shfl_xor(sq, 16); sq += __shfl_xor(sq, 32);
                    if (fq == 0) atomicAdd((u.pn == 0 ? ssq_q : ssq_kv) + row, sq);
                    if (u.pn == 1 && wc == 0) {
                        const int sp_ = seqpos(row); const f32x4 c = *(const f32x4*)(cosT + sp_ * 16 + 4 * fq), sn = *(const f32x4*)(sinT + sp_ * 16 + 4 * fq);
                        const f32x4 a = acc[ai][1][m][0], b = acc[ai][1][m][1];
                        u32x4 w; w.x = cvtpk(a[0] * c[0] - a[1] * sn[0], a[0] * sn[0] + a[1] * c[0]); w.y = cvtpk(a[2] * c[1] - a[3] * sn[1], a[2] * sn[1] + a[3] * c[1]);
                        w.z = cvtpk(b[0] * c[2] - b[1] * sn[2], b[0] * sn[2] + b[1] * c[2]); w.w = cvtpk(b[2] * c[3] - b[3] * sn[3], b[2] * sn[3] + b[3] * c[3]);
                        const int gt = row >> 6, r = row & 63;
#pragma unroll
                        for (int h = 0; h < 8; ++h) *(u32x4*)(Kt + ((size_t)((h * NGT + gt) * 12 + 8 + fq)) * 512 + r * 8) = w; }
                }
            }
    }
};
struct EpiQ {
    bf16_t* Q; const float* rstd; const float* cosT; const float* sinT;
    __device__ __forceinline__ void operator()(const Acc& acc, const Unit& u, int wr, int wc, int fr, int fq) const {
        const int row0 = u.pm * BM + wr * 64 + fr, col0 = u.pn * BM + wc * 32 + 8 * fq;
#pragma unroll
        for (int ai = 0; ai < 2; ++ai)
#pragma unroll
            for (int m = 0; m < 4; ++m) { const int row = row0 + ai * HALF + m * 16; const float rs = rsqrtf(rstd[row] * (1.f / 256.f) + EPS) * QSCALE; const int s = seqpos(row);
#pragma unroll
                for (int bj = 0; bj < 2; ++bj) { const int col = col0 + bj * HALF; const int d = col % 96;
                    f32x4 v0 = acc[ai][bj][m][0] * rs, v1 = acc[ai][bj][m][1] * rs;
                    if (d >= 64) { const int i0 = (d - 64) >> 1; const f32x4 c = *(const f32x4*)(cosT + s * 16 + i0), sn = *(const f32x4*)(sinT + s * 16 + i0);
                        const f32x4 a = v0, b = v1;
                        v0[0] = a[0] * c[0] - a[1] * sn[0]; v0[1] = a[0] * sn[0] + a[1] * c[0]; v0[2] = a[2] * c[1] - a[3] * sn[1]; v0[3] = a[2] * sn[1] + a[3] * c[1];
                        v1[0] = b[0] * c[2] - b[1] * sn[2]; v1[1] = b[0] * sn[2] + b[1] * c[2]; v1[2] = b[2] * c[3] - b[3] * sn[3]; v1[3] = b[2] * sn[3] + b[3] * c[3]; }
                    u32x4 w; w.x = cvtpk(v0[0], v0[1]); w.y = cvtpk(v0[2], v0[3]); w.z = cvtpk(v1[0], v1[1]); w.w = cvtpk(v1[2], v1[3]);
                    *(u32x4*)(Q + (size_t)row * QW + col) = w; } }
    }
};
struct EpiKV {
    bf16_t* Kt; bf16_t* Vt; const float* rstd;
    __device__ __forceinline__ void operator()(const Acc& acc, const Unit& u, int wr, int wc, int fr, int fq) const {
        const int row0 = u.pm * BM + wr * 64 + fr, col0 = u.pn * BM + wc * 32 + 8 * fq;
#pragma unroll
        for (int ai = 0; ai < 2; ++ai)
#pragma unroll
            for (int m = 0; m < 4; ++m) { const int row = row0 + ai * HALF + m * 16; const float rs = rsqrtf(rstd[row] * (1.f / 128.f) + EPS); const int gt = row >> 6, r = row & 63;
#pragma unroll
                for (int bj = 0; bj < 2; ++bj) { const int col = col0 + bj * HALF; const f32x4 v0 = acc[ai][bj][m][0] * rs, v1 = acc[ai][bj][m][1] * rs;
                    u32x4 w; w.x = cvtpk(v0[0], v0[1]); w.y = cvtpk(v0[2], v0[3]); w.z = cvtpk(v1[0], v1[1]); w.w = cvtpk(v1[2], v1[3]);
                    bf16_t* dst;
                    if (col < 512) { const int h = col >> 6, d = col & 63; dst = Kt + ((size_t)((h * NGT + gt) * 12 + (d >> 3))) * 512 + r * 8; }
                    else { const int v = col - 512, h = v >> 6, d = v & 63; dst = Vt + ((size_t)((h * NGT + gt) * 8 + (d >> 5) * 4 + (r >> 4))) * 512 + (r & 15) * 32 + (d & 31); }
                    *(u32x4*)dst = w; } }
    }
};

struct EpiConv {
    bf16_t* ACT; const float* cw; const float* cb; LAS float* xch;
#define LOADT(k, b_) { const float* wp_ = cw + chan0 + (k); tw[b_][0] = wp_[0]; tw[b_][1] = wp_[NUP]; tw[b_][2] = wp_[2 * NUP]; tw[b_][3] = cb[chan0 + (k)]; \
                       tw[b_][4] = wp_[DFF]; tw[b_][5] = wp_[NUP + DFF]; tw[b_][6] = wp_[2 * NUP + DFF]; tw[b_][7] = cb[DFF + chan0 + (k)]; }
    template <bool EDGE> __device__ __forceinline__ void compute(Acc& acc, int chan0, int colb, int s0, int S, int wr, int fr) const {
        float tw[2][8];
        LOADT(0, 0)
        const bool f0 = (fr == 0), f15 = (fr == 15);
#pragma unroll
        for (int n = 0; n < 2; ++n)
#pragma unroll
            for (int c = 0; c < 4; ++c) {
                constexpr int dummy_ = 0; (void)dummy_;
                const int k_ = 4 * n + c;
                if (k_ + 1 < 8) LOADT(k_ + 1, (k_ + 1) & 1)
                const float wg0 = tw[k_ & 1][0], wg1 = tw[k_ & 1][1], wg2 = tw[k_ & 1][2], bg = tw[k_ & 1][3], wu0 = tw[k_ & 1][4], wu1 = tw[k_ & 1][5], wu2 = tw[k_ & 1][6], bu = tw[k_ & 1][7];
#pragma unroll
                for (int ai = 0; ai < 2; ++ai) { const int blk = 2 * ai + wr;
                    const int sqb = s0 + 64 * blk + 4 * fr;
                    float gt = 0.f, ut = 0.f, gb = 0.f, ub = 0.f;
                    if (blk > 0) { gt = xch[((blk - 1) * 2 + 1) * 256 + colb + 4 * n + c]; ut = xch[((blk - 1) * 2 + 1) * 256 + 128 + colb + 4 * n + c]; }
                    if (blk < 3) { gb = xch[((blk + 1) * 2 + 0) * 256 + colb + 4 * n + c]; ub = xch[((blk + 1) * 2 + 0) * 256 + 128 + colb + 4 * n + c]; }
                    float hg0, hg1, hg2, hg3, hu0, hu1, hu2, hu3;
                    conv_rows<EDGE>(acc[ai][0][0][n][c], acc[ai][0][1][n][c], acc[ai][0][2][n][c], acc[ai][0][3][n][c], gt, gb, f0, f15, sqb, S, wg0, wg1, wg2, bg, hg0, hg1, hg2, hg3);
                    conv_rows<EDGE>(acc[ai][1][0][n][c], acc[ai][1][1][n][c], acc[ai][1][2][n][c], acc[ai][1][3][n][c], ut, ub, f0, f15, sqb, S, wu0, wu1, wu2, bu, hu0, hu1, hu2, hu3);
                    float r0 = gelu_tanh(hg0) * hu0, r1 = gelu_tanh(hg1) * hu1, r2 = gelu_tanh(hg2) * hu2, r3 = gelu_tanh(hg3) * hu3;
                    asm volatile("" : "+v"(r0), "+v"(r1), "+v"(r2), "+v"(r3));
                    acc[ai][0][0][n][c] = r0; acc[ai][0][1][n][c] = r1; acc[ai][0][2][n][c] = r2; acc[ai][0][3][n][c] = r3;
                    __builtin_amdgcn_sched_barrier(0);
                }
            }
    }
    __device__ __forceinline__ void operator()(Acc& acc, const Unit& u, int wr, int wc, int fr, int fq) const {
        int seqbase, t, S; ovl_decode(u.pm, seqbase, t, S);
        const int s0 = 254 * t - 1;
        const int colb = wc * 32 + 8 * fq;
        const int chan0 = u.pn * 128 + colb;
#pragma unroll
        for (int ai = 0; ai < 2; ++ai) { const int blk = 2 * ai + wr;
            if (fr == 0) {
#pragma unroll
                for (int bj = 0; bj < 2; ++bj)
#pragma unroll
                    for (int n = 0; n < 2; ++n) *(LAS f32x4*)(xch + (blk * 2 + 0) * 256 + bj * 128 + colb + 4 * n) = acc[ai][bj][0][n]; }
            if (fr == 15) {
#pragma unroll
                for (int bj = 0; bj < 2; ++bj)
#pragma unroll
                    for (int n = 0; n < 2; ++n) *(LAS f32x4*)(xch + (blk * 2 + 1) * 256 + bj * 128 + colb + 4 * n) = acc[ai][bj][3][n]; } }
        asm volatile("s_waitcnt lgkmcnt(0)\n\ts_barrier" ::: "memory");
        if ((s0 < 0) || ((s0 & (S - 1)) > S - 258)) compute<true>(acc, chan0, colb, s0, S, wr, fr); else compute<false>(acc, chan0, colb, s0, S, wr, fr);
#undef LOADT
#pragma unroll
        for (int ai = 0; ai < 2; ++ai) { const int blk = 2 * ai + wr;
#pragma unroll
            for (int m = 0; m < 4; ++m) { const int R = 64 * blk + 4 * fr + m, sq = s0 + R;
                if (R >= 1 && R <= 254 && sq < SP) { const f32x4 v0 = acc[ai][0][m][0], v1 = acc[ai][0][m][1];
                    u32x4 w; w.x = cvtpk(v0[0], v0[1]); w.y = cvtpk(v0[2], v0[3]); w.z = cvtpk(v1[0], v1[1]); w.w = cvtpk(v1[2], v1[3]);
                    *(u32x4*)(ACT + (size_t)(seqbase + sq) * DFF + chan0) = w; } }
        }
    }
};

template <class Epi, bool OVL = false>
__device__ __forceinline__ void gemm_phase(LAS unsigned char* lds, const Gemm g, const StaticOrder& S, const Epi& E, const int wid) {
    const int lane = lane_id_asm(), tid = wid * 64 + lane;
    const int wr = wid >> 2, wc = wid & 3, fr = lane & 15, fq = lane >> 4;
    const int nt = g.K / BK;
    const char* gA = (const char*)g.A; const char* gB = (const char*)g.Bt;
    asm volatile("" : "+s"(gA), "+s"(gB));
    unsigned voffA[2], voffB[2];
#pragma unroll
    for (int i = 0; i < 2; ++i) { int R, C; stage_rc(tid * 16 + i * 8192, R, C); const int Rb = (R & ~31) + perm32(R & 31);
        const int Ra = OVL ? ((R & 64) + 4 * (R & 15) + ((R >> 4) & 3)) : R;
        voffA[i] = (unsigned)(Ra * g.lda + C) * 2u; voffB[i] = (unsigned)(Rb * g.ldb + C) * 2u; }
    const size_t kstep = (size_t)(BK * 2);
    const size_t hstepA = (size_t)HALF * g.lda * 2, hstepB = (size_t)HALF * g.ldb * 2;
    const size_t tstepB = 2 * hstepB;
    const unsigned ldsw = (unsigned)wid * 1024u;
    const int aoff = lds_byte(wr * 64 + fr, fq * 8), boff = lds_byte(wc * 32 + fr, fq * 8);
#define PG8_SA(b, h) (((b) * 2 + (h)) * HTB)
#define PG8_SB(b, h) ((4 + (b) * 2 + (h)) * HTB)
#define PG8_STAGE(bufoff, gbase, voff) do { _Pragma("unroll") for (int _i = 0; _i < 2; ++_i) \
        __builtin_amdgcn_global_load_lds((const unsigned*)((const char*)(gbase) + (voff)[_i]), (LAS unsigned*)(lds + (bufoff) + ldsw + _i * 8192), 16, 0, 0); } while (0)
#define PG8_LDA(dst, b, h) do { _Pragma("unroll") for (int m = 0; m < 4; ++m) _Pragma("unroll") for (int k = 0; k < 2; ++k) dst[m][k] = *(const LAS bf16x8*)(lds + PG8_SA(b, h) + aoff + m * 2048 + k * 1024); } while (0)
#define PG8_LDB(dst, b, h) do { _Pragma("unroll") for (int n = 0; n < 2; ++n) _Pragma("unroll") for (int k = 0; k < 2; ++k) dst[n][k] = *(const LAS bf16x8*)(lds + PG8_SB(b, h) + boff + n * 2048 + k * 1024); } while (0)
#define PG8_MMA(ai, bj, At, Bt) do { __builtin_amdgcn_s_setprio(1); _Pragma("unroll") for (int m = 0; m < 4; ++m) _Pragma("unroll") for (int n = 0; n < 2; ++n) _Pragma("unroll") for (int k = 0; k < 2; ++k) \
        acc[ai][bj][m][n] = __builtin_amdgcn_mfma_f32_16x16x32_bf16(Bt[n][k], At[m][k], acc[ai][bj][m][n], 0, 0, 0); __builtin_amdgcn_s_setprio(0); } while (0)
#define PG8_WAIT_V(n) asm volatile("s_waitcnt vmcnt(" #n ")" ::: "memory")
#define PG8_WAIT_L(n) asm volatile("s_waitcnt lgkmcnt(" #n ")" ::: "memory")
#define PG8_BAR __builtin_amdgcn_s_barrier()
#define PG8_SCHED __builtin_amdgcn_sched_barrier(0)
    Unit cur, nxt; int ui = 0;
    if (!S.next(0, cur)) return;
    Acc acc;
#pragma unroll
    for (int a = 0; a < 2; ++a)
#pragma unroll
        for (int b = 0; b < 2; ++b)
#pragma unroll
            for (int m = 0; m < 4; ++m)
#pragma unroll
                for (int n = 0; n < 2; ++n) acc[a][b][m][n] = (f32x4){0.f, 0.f, 0.f, 0.f};
    bf16x8 At[4][2], B0[2][2], B1[2][2];
    const long rowB = (long)g.lda * 2; const char* cA = gA + tile_row0<OVL>(cur.pm) * rowB; const char* cB = gB + (size_t)cur.pn * tstepB;
    PG8_STAGE(PG8_SB(0, 0), cB, voffB); PG8_STAGE(PG8_SB(0, 1), cB + hstepB, voffB); PG8_STAGE(PG8_SA(0, 0), cA, voffA); PG8_STAGE(PG8_SA(0, 1), cA + hstepA, voffA);
    if (wr == 1) PG8_BAR;
    PG8_WAIT_V(2); PG8_BAR;
    PG8_STAGE(PG8_SB(1, 0), cB + kstep, voffB); PG8_STAGE(PG8_SA(1, 0), cA + kstep, voffA); PG8_STAGE(PG8_SB(1, 1), cB + hstepB + kstep, voffB);
    PG8_WAIT_V(6); PG8_BAR;
    for (;;) {
        const bool has_next = S.next(ui + 1, nxt);
        const char* nA = has_next ? gA + tile_row0<OVL>(nxt.pm) * rowB : cA; const char* nB = has_next ? gB + (size_t)nxt.pn * tstepB : cB;
        for (int t = 0; t < nt; t += 2) {
            const bool last = (t == nt - 2);
            const char* a1 = cA + (size_t)(t + 1) * kstep;
            const char* a2 = last ? nA : cA + (size_t)(t + 2) * kstep; const char* b2 = last ? nB : cB + (size_t)(t + 2) * kstep;
            const char* a3 = a2 + kstep; const char* b3 = b2 + kstep;
            PG8_LDB(B0, 0, 0); PG8_LDB(B1, 0, 1); PG8_SCHED; PG8_LDA(At, 0, 0); PG8_STAGE(PG8_SA(1, 1), a1 + hstepA, voffA);
            PG8_WAIT_V(8); PG8_WAIT_L(0); PG8_BAR; PG8_MMA(0, 0, At, B0); PG8_MMA(0, 1, At, B1); PG8_BAR; PG8_SCHED;
            PG8_LDA(At, 0, 1); PG8_STAGE(PG8_SB(0, 0), b2, voffB); PG8_STAGE(PG8_SB(0, 1), b2 + hstepB, voffB); PG8_STAGE(PG8_SA(0, 0), a2, voffA);
            PG8_WAIT_V(8); PG8_WAIT_L(0); PG8_BAR; PG8_MMA(1, 0, At, B0); PG8_MMA(1, 1, At, B1); PG8_BAR; PG8_SCHED;
            PG8_LDB(B0, 1, 0); PG8_LDB(B1, 1, 1); PG8_SCHED; PG8_LDA(At, 1, 0); PG8_STAGE(PG8_SA(0, 1), a2 + hstepA, voffA);
            PG8_WAIT_V(8); PG8_WAIT_L(0); PG8_BAR; PG8_MMA(0, 0, At, B0); PG8_MMA(0, 1, At, B1); PG8_BAR; PG8_SCHED;
            PG8_LDA(At, 1, 1); PG8_STAGE(PG8_SB(1, 0), b3, voffB); PG8_STAGE(PG8_SB(1, 1), b3 + hstepB, voffB); PG8_STAGE(PG8_SA(1, 0), a3, voffA);
            PG8_WAIT_V(8); PG8_WAIT_L(0); PG8_BAR; PG8_MMA(1, 0, At, B0); PG8_MMA(1, 1, At, B1); PG8_BAR; PG8_SCHED;
        }
        if (wr == 0) PG8_BAR;
        { const int l2 = lane_id_asm(); E(acc, cur, wr, wc, l2 & 15, l2 >> 4); }
        if (!has_next) break;
#pragma unroll
        for (int a = 0; a < 2; ++a)
#pragma unroll
            for (int b = 0; b < 2; ++b)
#pragma unroll
                for (int m = 0; m < 4; ++m)
#pragma unroll
                    for (int n = 0; n < 2; ++n) acc[a][b][m][n] = (f32x4){0.f, 0.f, 0.f, 0.f};
        cur = nxt; cA = nA; cB = nB; ++ui;
        if (wr == 1) PG8_BAR;
    }
    PG8_WAIT_V(0);
    PG8_BAR;
#undef PG8_SA
#undef PG8_SB
#undef PG8_STAGE
#undef PG8_LDA
#undef PG8_LDB
#undef PG8_MMA
#undef PG8_WAIT_V
#undef PG8_WAIT_L
#undef PG8_BAR
#undef PG8_SCHED
}
}

namespace mla2 {
constexpr int QBLK = 32, KVBLK = 64, NSLOT = 3, KSLOT = 12288, VSLOT = 8192;
constexpr int LDS_K = 0, LDS_V = NSLOT * KSLOT, LDS_WS = LDS_V + NSLOT * VSLOT, LDS_OST = LDS_WS + 8 * 64 * 4, LDS_BYTES = LDS_OST + 8 * 4096;
constexpr int THRL = 8;
typedef const LAS char* lds_cptr;
typedef short v4i16_t __attribute__((ext_vector_type(4)));
#define SBAR() __builtin_amdgcn_sched_barrier(0)
__device__ __forceinline__ int crow(int r, int hi) { return (r & 3) + 8 * (r >> 2) + 4 * hi; }
__device__ __forceinline__ void glds16(const void* gsrc, unsigned lds_dst) { unsigned keep;
    asm volatile("s_mov_b32 %0, m0\n\ts_mov_b32 m0, %2\n\ts_nop 0\n\tglobal_load_lds_dwordx4 %1, off\n\ts_mov_b32 m0, %0" : "=&s"(keep) : "v"(gsrc), "s"(lds_dst) : "memory"); }
__device__ __forceinline__ s16x4 vtr(lds_cptr p) { return __builtin_bit_cast(s16x4, __builtin_amdgcn_ds_read_tr16_b64_v4i16((LAS v4i16_t*)p)); }
__device__ __forceinline__ void kload2(bf16x8* kf, lds_cptr kp, int j) { kf[2 * j] = *(const LAS bf16x8*)(kp + j * 2048); kf[2 * j + 1] = *(const LAS bf16x8*)(kp + j * 2048 + 512); }
#define MX3(a, b, c) __builtin_fmaxf(__builtin_fmaxf((a), (b)), (c))
__device__ __forceinline__ float rowmax(const f32x16& p0, const f32x16& p1) {
    float a = MX3(p0[0], p0[1], p1[0]), b = MX3(p0[2], p0[3], p1[1]); a = MX3(a, p1[2], p1[3]);
#pragma unroll
    for (int r = 4; r < 16; r += 4) { a = MX3(a, p0[r], p0[r + 1]); b = MX3(b, p0[r + 2], p0[r + 3]); a = MX3(a, p1[r], p1[r + 1]); b = MX3(b, p1[r + 2], p1[r + 3]); }
    float rm = __builtin_fmaxf(a, b);
    auto rr = __builtin_amdgcn_permlane32_swap(__float_as_uint(rm), __float_as_uint(rm), false, false);
    return __builtin_fmaxf(__uint_as_float(rr[0]), __uint_as_float(rr[1]));
}
#define WAITB(NK, NV) do { if (kw) asm volatile("s_waitcnt vmcnt(" #NK ") lgkmcnt(0)\n\ts_barrier" ::: "memory"); else asm volatile("s_waitcnt vmcnt(" #NV ") lgkmcnt(0)\n\ts_barrier" ::: "memory"); } while (0)

__device__ __forceinline__ void attn_unit(const bf16_t* __restrict__ Qb, const bf16_t* __restrict__ Kh, const bf16_t* __restrict__ Vh, bf16_t* __restrict__ Ob, int seq, LAS char* shm, const int wid) {
    const int lane = lane_id_asm(), r32 = lane & 31, hi = lane >> 5;
    const bool kw = wid < 4;
    const unsigned lds0 = (unsigned)(size_t)shm;
    LAS float* wsf = (LAS float*)(shm + LDS_WS) + wid * 64;
    const bf16_t* ksrc = Kh + wid * 512 + lane * 8;
    const int vi0 = 2 * (wid & 3);
    const bf16_t* vsrc0 = Vh + vi0 * 512 + lane * 8;
    const bf16_t* vsrc1 = vsrc0 + 512;
    const unsigned kdst = lds0 + LDS_K + wid * 1024, vdst = lds0 + LDS_V + vi0 * 1024;
#define DMA_K(t, si) do { if (kw) { const bf16_t* s_ = ksrc + (long)(t) * 6144; const unsigned d_ = (unsigned)__builtin_amdgcn_readfirstlane(kdst + (si) * KSLOT); \
        glds16(s_, d_); glds16(s_ + 2048, d_ + 4096); glds16(s_ + 4096, d_ + 8192); } } while (0)
#define DMA_V(t, si) do { if (!kw) { const unsigned d_ = (unsigned)__builtin_amdgcn_readfirstlane(vdst + (si) * VSLOT); \
        glds16(vsrc0 + (long)(t) * 4096, d_); glds16(vsrc1 + (long)(t) * 4096, d_ + 1024); } } while (0)
    const lds_cptr shm3 = (lds_cptr)shm;
    const lds_cptr kp0 = shm3 + LDS_K + hi * 1024 + r32 * 16;
    const lds_cptr vp0 = shm3 + LDS_V + ((lane >> 4) & 1) * 32 + (lane & 3) * 8 + (4 * hi + ((lane & 15) >> 2)) * 64;
    const int NT = seq / KVBLK;
    bf16x8 qr[6];
    { const bf16_t* Qw = Qb + (long)(wid * QBLK + r32) * QW + hi * 8;
#pragma unroll
      for (int d0 = 0; d0 < 6; ++d0) qr[d0] = *(const bf16x8*)(Qw + d0 * 16); }
    asm volatile("s_waitcnt vmcnt(0)" ::: "memory");
    DMA_K(0, 0); DMA_V(0, 0); DMA_K(1, 1); DMA_K(2, 2);
    float mhat = 0.f, l_reg = 0.f; f32x16 o[2]; o[0] = f32x16{}; o[1] = f32x16{}; f32x16 negm = f32x16{}; asm volatile("" : "+v"(negm));
    f32x16 pA0, pA1, pB0, pB1; bf16x8 kf[12];
    bool resc = false;
    WAITB(6, 2);
    {
        kload2(kf, kp0, 0); kload2(kf, kp0, 1); kload2(kf, kp0, 2); kload2(kf, kp0, 3); kload2(kf, kp0, 4); kload2(kf, kp0, 5);
#pragma unroll
        for (int d0 = 0; d0 < 6; ++d0) {
            if (d0 == 0) { pA0 = __builtin_amdgcn_mfma_f32_32x32x16_bf16(kf[0], qr[0], negm, 0, 0, 0); pA1 = __builtin_amdgcn_mfma_f32_32x32x16_bf16(kf[1], qr[0], negm, 0, 0, 0); }
            else { pA0 = __builtin_amdgcn_mfma_f32_32x32x16_bf16(kf[2 * d0], qr[d0], pA0, 0, 0, 0); pA1 = __builtin_amdgcn_mfma_f32_32x32x16_bf16(kf[2 * d0 + 1], qr[d0], pA1, 0, 0, 0); } }
        const float rm = rowmax(pA0, pA1); mhat = rm;
#pragma unroll
        for (int r = 0; r < 16; ++r) { pA0[r] = __builtin_amdgcn_exp2f(pA0[r] - rm); pA1[r] = (r < 8) ? __builtin_amdgcn_exp2f(pA1[r] - rm) : (pA1[r] - rm); }
#pragma unroll
        for (int r = 0; r < 16; ++r) negm[r] = -mhat;
        asm volatile("" : "+v"(negm));
    }
    WAITB(0, 0);
    DMA_K(3, 0); DMA_V(1, 1);
    int sp = 0, sc = 1, sn = 2;
    kload2(kf, kp0 + sc * KSLOT, 0); kload2(kf, kp0 + sc * KSLOT, 1); kload2(kf, kp0 + sc * KSLOT, 2); kload2(kf, kp0 + sc * KSLOT, 3); kload2(kf, kp0 + sc * KSLOT, 4); kload2(kf, kp0 + sc * KSLOT, 5);
    WAITB(3, 2);
#define ROT() do { sp = sc; sc = sn; sn = (sn == NSLOT - 1) ? 0 : sn + 1; } while (0)
#define RESC() do { if (resc) { asm volatile("s_waitcnt lgkmcnt(0)" ::: "memory"); \
        _Pragma("unroll") for (int d_ = 0; d_ < 2; ++d_) _Pragma("unroll") for (int r = 0; r < 16; ++r) o[d_][r] *= wsf[crow(r, hi)]; } } while (0)
    s16x4 vlo[4], vhi[4]; u32x4 pw0, pw1, pw2, pw3;
#define PKW(P, B) cvtpk(P[B], P[B + 1])
#define PAF(k) __builtin_bit_cast(bf16x8, pw##k)
#define VFR(i) (bf16x8){vlo[(i) & 3][0], vlo[(i) & 3][1], vlo[(i) & 3][2], vlo[(i) & 3][3], vhi[(i) & 3][0], vhi[(i) & 3][1], vhi[(i) & 3][2], vhi[(i) & 3][3]}
#define PIN(x) asm volatile("" : "+v"(x))
#define EX(v) __builtin_amdgcn_exp2f(v)
#define VRD(i) do { vlo[(i) & 3] = vtr(vp_ + (((i) >> 2) * 4096 + ((i) & 3) * 1024)); vhi[(i) & 3] = vtr(vp_ + (((i) >> 2) * 4096 + ((i) & 3) * 1024 + 512)); } while (0)
#define KRD(G, j) do { if (G) { kload2(kf, kp0 + sn * KSLOT, j); SBAR(); } } while (0)
#define QK(C, i, d, CIN) C = __builtin_amdgcn_mfma_f32_32x32x16_bf16(kf[i], qr[d], CIN, 0, 0, 0)
#define GAPB(MF, X, B) do { MF; X[B] = EX(X[B]); X[B + 1] = EX(X[B + 1]); X[B + 2] = EX(X[B + 2]); X[B + 3] = EX(X[B + 3]); PIN(X); SBAR(); } while (0)
#define STEP(C0, C1, P0, P1, t, GK, GV, GL) do { SBAR(); \
    const lds_cptr vp_ = vp0 + sp * VSLOT; float sacc; \
    VRD(0); SBAR(); QK(C0, 0, 0, negm);  sacc = P0[0] + P0[1]; sacc += P0[2]; sacc += P0[3]; PIN(sacc); pw0[0] = PKW(P0, 0); PIN(pw0); SBAR(); \
    VRD(1); SBAR(); QK(C1, 1, 0, negm);  sacc += P0[4]; sacc += P0[5]; sacc += P0[6]; PIN(sacc); pw0[1] = PKW(P0, 2); PIN(pw0); SBAR(); \
    VRD(2); SBAR(); QK(C0, 2, 1, C0);    sacc += P0[7]; sacc += P0[8]; sacc += P0[9]; PIN(sacc); pw0[2] = PKW(P0, 4); PIN(pw0); SBAR(); \
    VRD(3); SBAR(); QK(C1, 3, 1, C1);    sacc += P0[10]; sacc += P0[11]; sacc += P0[12]; PIN(sacc); pw0[3] = PKW(P0, 6); PIN(pw0); SBAR(); \
    QK(C0, 4, 2, C0);    P1[8] = EX(P1[8]); sacc += P0[13]; sacc += P0[14]; sacc += P0[15]; PIN(sacc); pw1[0] = PKW(P0, 8); PIN(pw1); SBAR(); \
    QK(C1, 5, 2, C1);    P1[9] = EX(P1[9]); sacc += P1[0]; sacc += P1[1]; sacc += P1[2]; PIN(sacc); pw1[1] = PKW(P0, 10); PIN(pw1); SBAR(); \
    QK(C0, 6, 3, C0);    P1[10] = EX(P1[10]); sacc += P1[3]; sacc += P1[4]; sacc += P1[5]; PIN(sacc); pw1[2] = PKW(P0, 12); PIN(pw1); SBAR(); \
    QK(C1, 7, 3, C1);    P1[11] = EX(P1[11]); sacc += P1[6]; sacc += P1[7]; PIN(sacc); pw1[3] = PKW(P0, 14); PIN(pw1); SBAR(); \
    QK(C0, 8, 4, C0);    P1[12] = EX(P1[12]); P1[13] = EX(P1[13]); sacc += P1[8]; sacc += P1[9]; PIN(sacc); pw2[0] = PKW(P1, 0); pw2[1] = PKW(P1, 2); PIN(pw2); SBAR(); \
    QK(C1, 9, 4, C1);    P1[14] = EX(P1[14]); P1[15] = EX(P1[15]); sacc += P1[10]; sacc += P1[11]; PIN(sacc); pw2[2] = PKW(P1, 4); pw2[3] = PKW(P1, 6); PIN(pw2); SBAR(); \
    QK(C0, 10, 5, C0);   sacc += P1[12]; sacc += P1[13]; PIN(sacc); pw3[0] = PKW(P1, 8); pw3[1] = PKW(P1, 10); PIN(pw3); SBAR(); \
    QK(C1, 11, 5, C1);   sacc += P1[14]; sacc += P1[15]; PIN(sacc); pw3[2] = PKW(P1, 12); pw3[3] = PKW(P1, 14); PIN(pw3); SBAR(); \
    l_reg += sacc; \
    if (GK) { DMA_K((t) + 3, sc); } if (GV) { DMA_V((t) + 1, sn); } \
    SBAR(); \
      \
    o[0] = __builtin_amdgcn_mfma_f32_32x32x16_bf16(PAF(0), VFR(0), o[0], 0, 0, 0); \
    float a = MX3(C0[0], C0[1], C0[2]), b = MX3(C0[3], C0[4], C0[5]), c = MX3(C1[0], C1[1], C1[2]), d = MX3(C1[3], C1[4], C1[5]); \
    a = MX3(a, C0[6], C0[7]); b = MX3(b, C0[8], C0[9]); c = MX3(c, C1[6], C1[7]); d = MX3(d, C1[8], C1[9]); PIN(a); PIN(b); PIN(c); PIN(d); VRD(4); SBAR(); \
    KRD(GL, 0); o[0] = __builtin_amdgcn_mfma_f32_32x32x16_bf16(PAF(1), VFR(1), o[0], 0, 0, 0); \
    a = MX3(a, C0[10], C0[11]); b = MX3(b, C0[12], C0[13]); c = MX3(c, C1[10], C1[11]); d = MX3(d, C1[12], C1[13]); \
    a = MX3(a, C0[14], C0[15]); c = MX3(c, C1[14], C1[15]); \
    { float rm = MX3(a, b, __builtin_fmaxf(c, d)); { auto rr = __builtin_amdgcn_permlane32_swap(__float_as_uint(rm), __float_as_uint(rm), false, false); rm = __builtin_fmaxf(__uint_as_float(rr[0]), __uint_as_float(rr[1])); } \
      resc = false; \
      if (__builtin_expect(__any(rm > (float)THRL), 0)) { const float dl = __builtin_fmaxf(rm, 0.f); mhat += dl; \
        _Pragma("unroll") for (int r = 0; r < 16; ++r) { C0[r] -= dl; C1[r] -= dl; } \
        _Pragma("unroll") for (int r = 0; r < 16; ++r) negm[r] = -mhat; asm volatile("" : "+v"(negm)); \
        const float f = __builtin_amdgcn_exp2f(-dl); l_reg *= f; if (hi == 0) wsf[r32] = f; resc = true; } } \
    VRD(5); SBAR(); \
    KRD(GL, 1); GAPB(o[0] = __builtin_amdgcn_mfma_f32_32x32x16_bf16(PAF(2), VFR(2), o[0], 0, 0, 0), C0, 0); VRD(6); SBAR(); \
    KRD(GL, 2); GAPB(o[0] = __builtin_amdgcn_mfma_f32_32x32x16_bf16(PAF(3), VFR(3), o[0], 0, 0, 0), C0, 4); VRD(7); SBAR(); \
    KRD(GL, 3); GAPB(o[1] = __builtin_amdgcn_mfma_f32_32x32x16_bf16(PAF(0), VFR(4), o[1], 0, 0, 0), C0, 8); \
    KRD(GL, 4); GAPB(o[1] = __builtin_amdgcn_mfma_f32_32x32x16_bf16(PAF(1), VFR(5), o[1], 0, 0, 0), C0, 12); \
    KRD(GL, 5); GAPB(o[1] = __builtin_amdgcn_mfma_f32_32x32x16_bf16(PAF(2), VFR(6), o[1], 0, 0, 0), C1, 0); \
    GAPB(o[1] = __builtin_amdgcn_mfma_f32_32x32x16_bf16(PAF(3), VFR(7), o[1], 0, 0, 0), C1, 4);   \
    } while (0)
    int t = 1;
    for (; t + 4 < NT; t += 2) {
        STEP(pB0, pB1, pA0, pA1, t, true, true, true);       WAITB(3, 2); RESC(); ROT();
        STEP(pA0, pA1, pB0, pB1, t + 1, true, true, true);   WAITB(3, 2); RESC(); ROT();
    }
    STEP(pB0, pB1, pA0, pA1, t, false, true, true);       WAITB(0, 2); RESC(); ROT();
    STEP(pA0, pA1, pB0, pB1, t + 1, false, true, true);   WAITB(0, 0); RESC(); ROT();
    STEP(pB0, pB1, pA0, pA1, NT - 1, false, false, false); RESC();
    {
#pragma unroll
        for (int r = 8; r < 16; ++r) pB1[r] = __builtin_amdgcn_exp2f(pB1[r]);
        float sacc = pB0[0] + pB0[1];
#pragma unroll
        for (int r = 2; r < 16; ++r) sacc += pB0[r];
#pragma unroll
        for (int r = 0; r < 16; ++r) sacc += pB1[r];
        l_reg += sacc;
        pw0 = (u32x4){PKW(pB0, 0), PKW(pB0, 2), PKW(pB0, 4), PKW(pB0, 6)}; pw1 = (u32x4){PKW(pB0, 8), PKW(pB0, 10), PKW(pB0, 12), PKW(pB0, 14)};
        pw2 = (u32x4){PKW(pB1, 0), PKW(pB1, 2), PKW(pB1, 4), PKW(pB1, 6)}; pw3 = (u32x4){PKW(pB1, 8), PKW(pB1, 10), PKW(pB1, 12), PKW(pB1, 14)};
        const lds_cptr vp_ = vp0 + sc * VSLOT;
        VRD(0); VRD(1); VRD(2); VRD(3);
        o[0] = __builtin_amdgcn_mfma_f32_32x32x16_bf16(PAF(0), VFR(0), o[0], 0, 0, 0); o[0] = __builtin_amdgcn_mfma_f32_32x32x16_bf16(PAF(1), VFR(1), o[0], 0, 0, 0);
        o[0] = __builtin_amdgcn_mfma_f32_32x32x16_bf16(PAF(2), VFR(2), o[0], 0, 0, 0); o[0] = __builtin_amdgcn_mfma_f32_32x32x16_bf16(PAF(3), VFR(3), o[0], 0, 0, 0);
        SBAR(); VRD(4); VRD(5); VRD(6); VRD(7);
        o[1] = __builtin_amdgcn_mfma_f32_32x32x16_bf16(PAF(0), VFR(4), o[1], 0, 0, 0); o[1] = __builtin_amdgcn_mfma_f32_32x32x16_bf16(PAF(1), VFR(5), o[1], 0, 0, 0);
        o[1] = __builtin_amdgcn_mfma_f32_32x32x16_bf16(PAF(2), VFR(6), o[1], 0, 0, 0); o[1] = __builtin_amdgcn_mfma_f32_32x32x16_bf16(PAF(3), VFR(7), o[1], 0, 0, 0);
    }
    { auto rr = __builtin_amdgcn_permlane32_swap(__float_as_uint(l_reg), __float_as_uint(l_reg), false, false); l_reg = __uint_as_float(rr[0]) + __uint_as_float(rr[1]); }
    if (hi == 0) wsf[32 + r32] = l_reg;
    asm volatile("s_waitcnt lgkmcnt(0)" ::: "memory");
    float rli[16];
#pragma unroll
    for (int r = 0; r < 16; ++r) rli[r] = __builtin_amdgcn_rcpf(wsf[32 + crow(r, hi)]);
    bf16_t* Ow = Ob + (long)(wid * QBLK) * DM;
    {   LAS bf16_t* stg = (LAS bf16_t*)(shm + LDS_OST) + wid * 2048;
#pragma unroll
        for (int r = 0; r < 16; ++r) { const int orow = crow(r, hi);
#pragma unroll
            for (int d0 = 0; d0 < 2; ++d0) stg[orow * 64 + d0 * 32 + r32] = (bf16_t)(cvtpk(o[d0][r] * rli[r], 0.f) & 0xffffu); }
        asm volatile("s_waitcnt lgkmcnt(0)" ::: "memory");
#pragma unroll
        for (int i = 0; i < 4; ++i) { const int row = i * 8 + (lane >> 3), ch = lane & 7; const u32x4 v = *(const LAS u32x4*)(stg + row * 64 + ch * 8); *(u32x4*)(Ow + (long)row * DM + ch * 8) = v; } }
    asm volatile("s_waitcnt vmcnt(0) lgkmcnt(0)\n\ts_barrier" ::: "memory");
#undef DMA_K
#undef DMA_V
#undef ROT
#undef RESC
#undef PKW
#undef PAF
#undef VFR
#undef PIN
#undef EX
#undef VRD
#undef KRD
#undef QK
#undef GAPB
#undef STEP
}
#undef SBAR
#undef MX3
#undef WAITB
}

namespace na {
constexpr int VP = 144, VBUF = 32 * VP;
constexpr int LDS_RPB = 0, LDS_VB = 16384, LDS_BYTES = LDS_VB + 8 * 2 * VBUF;
typedef short v4i16_t __attribute__((ext_vector_type(4)));
__device__ __forceinline__ void unit(const bf16_t* __restrict__ Z, bf16_t* __restrict__ MIX, const LAS float* rpb, LAS char* vbuf, int tokbase, int rows, int r, int j, int h) {
    const int lane = lane_id_asm();
    const int q = lane & 15, g = lane >> 4;
    const int rs = min(max(r - 4, 0), rows - 8);
    const int bcs = min(max(16 * j - 8, 0), 32);
    const int qtok = tokbase + r * 64 + 16 * j + q;
    const bf16_t* qp = Z + (size_t)qtok * ZP + Z_NQ + h * 64 + 8 * g;
    const bf16x8 qf0 = *(const bf16x8*)qp, qf1 = *(const bf16x8*)(qp + 32);
    const bf16_t* vsrc = Z + (size_t)(tokbase + rs * 64 + bcs) * ZP + Z_NV + h * 64;
    bf16x8 vr[2][4];
#define NA_VLOAD(s) do { _Pragma("unroll") for (int it = 0; it < 4; ++it) { const int id = it * 64 + lane; vr[(s) & 1][it] = *(const bf16x8*)(vsrc + (size_t)((s) * 64 + (id >> 3)) * ZP + (id & 7) * 8); } } while (0)
#define NA_VWRITE(b) do { _Pragma("unroll") for (int it = 0; it < 4; ++it) { const int id = it * 64 + lane; *(LAS bf16x8*)(vbuf + ((b) & 1) * VBUF + (id >> 3) * VP + (id & 7) * 16) = vr[(b) & 1][it]; } } while (0)
    NA_VLOAD(0); NA_VLOAD(1);
    f32x4 acc[16];
    const bf16_t* kbase = Z + (size_t)(tokbase + rs * 64 + bcs + q) * ZP + Z_NK + h * 64 + 8 * g;
#pragma unroll
    for (int t = 0; t < 16; ++t) {
        const bf16_t* kp = kbase + (size_t)((t >> 1) * 64 + 16 * (t & 1)) * ZP;
        const bf16x8 k0 = *(const bf16x8*)kp, k1 = *(const bf16x8*)(kp + 32);
        f32x4 a = {0.f, 0.f, 0.f, 0.f};
        a = __builtin_amdgcn_mfma_f32_16x16x32_bf16(k0, qf0, a, 0, 0, 0);
        a = __builtin_amdgcn_mfma_f32_16x16x32_bf16(k1, qf1, a, 0, 0, 0);
        acc[t] = a;
    }
    const int qcol = 16 * j + q, qs = min(max(qcol - 8, 0), 48);
    float mx = -INFINITY;
#pragma unroll
    for (int t = 0; t < 16; ++t) {
        const int dr = rs + (t >> 1) - r + 7;
#pragma unroll
        for (int i = 0; i < 4; ++i) {
            const int kcol = bcs + 16 * (t & 1) + 4 * g + i;
            const bool valid = (kcol >= qs) && (kcol < qs + 16);
            const int dc = min(max(kcol - qcol + 15, 0), 30);
            float bias = rpb[dr * 31 + dc];
            asm volatile("" : "+v"(bias));
            const float s = valid ? (acc[t][i] * 0.125f + bias) * LOG2E : -INFINITY;
            acc[t][i] = s; mx = fmaxf(mx, s);
        }
    }
    mx = fmaxf(mx, __shfl_xor(mx, 16)); mx = fmaxf(mx, __shfl_xor(mx, 32));
    float l = 0.f;
#pragma unroll
    for (int t = 0; t < 16; ++t)
#pragma unroll
        for (int i = 0; i < 4; ++i) { const float p = __builtin_amdgcn_exp2f(acc[t][i] - mx); acc[t][i] = p; l += p; }
    l += __shfl_xor(l, 16); l += __shfl_xor(l, 32);
    f32x4 o[4];
#pragma unroll
    for (int db = 0; db < 4; ++db) o[db] = (f32x4){0.f, 0.f, 0.f, 0.f};
    const int li = lane & 15;
    LAS char* trb = vbuf + (4 * g + (li >> 2)) * VP + (li & 3) * 8;
    NA_VWRITE(0);
#pragma unroll
    for (int s = 0; s < 8; ++s) {
        if (s + 2 < 8) NA_VLOAD(s + 2);
        u32x4 pw; pw.x = cvtpk(acc[2 * s][0], acc[2 * s][1]); pw.y = cvtpk(acc[2 * s][2], acc[2 * s][3]); pw.z = cvtpk(acc[2 * s + 1][0], acc[2 * s + 1][1]); pw.w = cvtpk(acc[2 * s + 1][2], acc[2 * s + 1][3]);
        const bf16x8 pb = __builtin_bit_cast(bf16x8, pw);
        LAS char* tb = trb + (s & 1) * VBUF;
#pragma unroll
        for (int db = 0; db < 4; ++db) {
            const v4i16_t t0 = __builtin_amdgcn_ds_read_tr16_b64_v4i16((LAS v4i16_t*)(tb + db * 32));
            const v4i16_t t1 = __builtin_amdgcn_ds_read_tr16_b64_v4i16((LAS v4i16_t*)(tb + 16 * VP + db * 32));
            const bf16x8 vf = (bf16x8){t0[0], t0[1], t0[2], t0[3], t1[0], t1[1], t1[2], t1[3]};
            o[db] = __builtin_amdgcn_mfma_f32_16x16x32_bf16(vf, pb, o[db], 0, 0, 0);
        }
        if (s + 1 < 8) NA_VWRITE(s + 1);
    }
    const float rl = __builtin_amdgcn_rcpf(l);
    bf16_t* op = MIX + (size_t)qtok * DM + 512 + h * 64 + 4 * g;
#pragma unroll
    for (int db = 0; db < 4; ++db) { u32x2 w; w.x = cvtpk(o[db][0] * rl, o[db][1] * rl); w.y = cvtpk(o[db][2] * rl, o[db][3] * rl); *(u32x2*)(op + db * 16) = w; }
#undef NA_VLOAD
#undef NA_VWRITE
}

__device__ __forceinline__ float shx(float v, int mask, int lane) { return __builtin_bit_cast(float, __builtin_amdgcn_ds_bpermute((lane ^ mask) << 2, __builtin_bit_cast(int, v))); }
template <int D>
__device__ __forceinline__ void unit2(const bf16_t* __restrict__ Z, bf16_t* __restrict__ MIX, const LAS float* rpb, LAS char* vbuf, int tokbase, int rows, int r0, int j, int h) {
    constexpr int NB = 8 + D;
    const int lane = lane_id_asm();
    const int q = lane & 15, g = lane >> 4;
    const int rs0 = min(max(r0 - 4, 0), rows - 8);
    const int bcs = min(max(16 * j - 8, 0), 32);
    const int qtok = tokbase + r0 * 64 + 16 * j + q;
    bf16x8 qf[2][2];
#pragma unroll
    for (int qr = 0; qr < 2; ++qr) { const bf16_t* qp = Z + (size_t)(qtok + 64 * qr) * ZP + Z_NQ + h * 64 + 8 * g; qf[qr][0] = *(const bf16x8*)qp; qf[qr][1] = *(const bf16x8*)(qp + 32); }
    const bf16_t* vsrc = Z + (size_t)(tokbase + rs0 * 64 + bcs) * ZP + Z_NV + h * 64;
    bf16x8 vr[2][4];
#define NA_VLOAD(s) do { _Pragma("unroll") for (int it = 0; it < 4; ++it) { const int id = it * 64 + lane; vr[(s) & 1][it] = *(const bf16x8*)(vsrc + (size_t)((s) * 64 + (id >> 3)) * ZP + (id & 7) * 8); } } while (0)
#define NA_VWRITE(b) do { _Pragma("unroll") for (int it = 0; it < 4; ++it) { const int id = it * 64 + lane; *(LAS bf16x8*)(vbuf + ((b) & 1) * VBUF + (id >> 3) * VP + (id & 7) * 16) = vr[(b) & 1][it]; } } while (0)
    f32x4 acc[2][16];
    const bf16_t* kbase = Z + (size_t)(tokbase + rs0 * 64 + bcs + q) * ZP + Z_NK + h * 64 + 8 * g;
#pragma unroll
    for (int u = 0; u < NB; ++u)
#pragma unroll
        for (int tp = 0; tp < 2; ++tp) {
            const bf16_t* kp = kbase + (size_t)(u * 64 + 16 * tp) * ZP;
            const bf16x8 k0 = *(const bf16x8*)kp, k1 = *(const bf16x8*)(kp + 32);
            if (u < 8) { f32x4 a = {0.f, 0.f, 0.f, 0.f}; a = __builtin_amdgcn_mfma_f32_16x16x32_bf16(k0, qf[0][0], a, 0, 0, 0); a = __builtin_amdgcn_mfma_f32_16x16x32_bf16(k1, qf[0][1], a, 0, 0, 0); acc[0][2 * u + tp] = a; }
            if (u >= D) { f32x4 a = {0.f, 0.f, 0.f, 0.f}; a = __builtin_amdgcn_mfma_f32_16x16x32_bf16(k0, qf[1][0], a, 0, 0, 0); a = __builtin_amdgcn_mfma_f32_16x16x32_bf16(k1, qf[1][1], a, 0, 0, 0); acc[1][2 * (u >= D ? u - D : 0) + tp] = a; }
            if (tp == 1 && (u & 1)) __builtin_amdgcn_sched_barrier(0);
        }
    const int qcol = 16 * j + q, qs = min(max(qcol - 8, 0), 48);
    float rl[2];
#pragma unroll
    for (int qr = 0; qr < 2; ++qr) {
        float mx = -INFINITY;
#pragma unroll
        for (int t = 0; t < 16; ++t) {
            const int dr = (rs0 + qr * D) + (t >> 1) - (r0 + qr) + 7;
#pragma unroll
            for (int i = 0; i < 4; ++i) {
                const int kcol = bcs + 16 * (t & 1) + 4 * g + i;
                const bool valid = (kcol >= qs) && (kcol < qs + 16);
                const int dc = min(max(kcol - qcol + 15, 0), 30);
                const float s_all = (acc[qr][t][i] * 0.125f + rpb[dr * 31 + dc]) * LOG2E;
                const float sv = valid ? s_all : -INFINITY;
                acc[qr][t][i] = sv; mx = fmaxf(mx, sv);
            }
        }
        mx = fmaxf(mx, shx(mx, 16, lane)); mx = fmaxf(mx, shx(mx, 32, lane));
        float l = 0.f;
#pragma unroll
        for (int t = 0; t < 16; ++t)
#pragma unroll
            for (int i = 0; i < 4; ++i) { const float p = __builtin_amdgcn_exp2f(acc[qr][t][i] - mx); acc[qr][t][i] = p; l += p; }
        l += shx(l, 16, lane); l += shx(l, 32, lane);
        rl[qr] = __builtin_amdgcn_rcpf(l);
    }
    f32x4 o[2][4];
#pragma unroll
    for (int qr = 0; qr < 2; ++qr)
#pragma unroll
        for (int db = 0; db < 4; ++db) o[qr][db] = (f32x4){0.f, 0.f, 0.f, 0.f};
    NA_VLOAD(0); NA_VLOAD(1);
    const int li = lane & 15;
    LAS char* trb = vbuf + (4 * g + (li >> 2)) * VP + (li & 3) * 8;
    NA_VWRITE(0);
#pragma unroll
    for (int u = 0; u < NB; ++u) {
        if (u + 2 < NB) NA_VLOAD(u + 2);
        LAS char* tb = trb + (u & 1) * VBUF;
        bf16x8 pb0 = {}, pb1 = {};
        if (u < 8) { u32x4 pw; pw.x = cvtpk(acc[0][2 * u][0], acc[0][2 * u][1]); pw.y = cvtpk(acc[0][2 * u][2], acc[0][2 * u][3]); pw.z = cvtpk(acc[0][2 * u + 1][0], acc[0][2 * u + 1][1]); pw.w = cvtpk(acc[0][2 * u + 1][2], acc[0][2 * u + 1][3]);
            pb0 = __builtin_bit_cast(bf16x8, pw); }
        if (u >= D) { const int ir = (u >= D) ? u - D : 0;
            u32x4 pw; pw.x = cvtpk(acc[1][2 * ir][0], acc[1][2 * ir][1]); pw.y = cvtpk(acc[1][2 * ir][2], acc[1][2 * ir][3]); pw.z = cvtpk(acc[1][2 * ir + 1][0], acc[1][2 * ir + 1][1]); pw.w = cvtpk(acc[1][2 * ir + 1][2], acc[1][2 * ir + 1][3]);
            pb1 = __builtin_bit_cast(bf16x8, pw); }
#pragma unroll
        for (int db = 0; db < 4; ++db) {
            const v4i16_t t0 = __builtin_amdgcn_ds_read_tr16_b64_v4i16((LAS v4i16_t*)(tb + db * 32));
            const v4i16_t t1 = __builtin_amdgcn_ds_read_tr16_b64_v4i16((LAS v4i16_t*)(tb + 16 * VP + db * 32));
            const bf16x8 vf = (bf16x8){t0[0], t0[1], t0[2], t0[3], t1[0], t1[1], t1[2], t1[3]};
            if (u < 8) o[0][db] = __builtin_amdgcn_mfma_f32_16x16x32_bf16(vf, pb0, o[0][db], 0, 0, 0);
            if (u >= D) o[1][db] = __builtin_amdgcn_mfma_f32_16x16x32_bf16(vf, pb1, o[1][db], 0, 0, 0);
        }
        if (u + 1 < NB) NA_VWRITE(u + 1);
        __builtin_amdgcn_sched_barrier(0);
    }
#pragma unroll
    for (int qr = 0; qr < 2; ++qr) { bf16_t* op = MIX + (size_t)(qtok + 64 * qr) * DM + 512 + h * 64 + 4 * g;
#pragma unroll
        for (int db = 0; db < 4; ++db) { u32x2 w; w.x = cvtpk(o[qr][db][0] * rl[qr], o[qr][db][1] * rl[qr]); w.y = cvtpk(o[qr][db][2] * rl[qr], o[qr][db][3] * rl[qr]); *(u32x2*)(op + db * 16) = w; } }
#undef NA_VLOAD
#undef NA_VWRITE
}
}

#define XB_TMO      128
#define XB_XCNT(j)  (256  + 64 * (j))
#define XB_XSUB(j)  (1280 + 64 * (j))
#define XB_XGEN(j)  (2304 + 64 * (j))
#define XB_TOP      3328
#define XB_TOPGEN   3392
#define XCD_BAR_WORDS 3456
#define XB_SPIN_CAP (1u << 20)
__device__ __forceinline__ unsigned xb_ld(unsigned* p)              { return __hip_atomic_load(p, __ATOMIC_RELAXED, __HIP_MEMORY_SCOPE_AGENT); }
__device__ __forceinline__ unsigned xb_add(unsigned* p, unsigned v) { return __hip_atomic_fetch_add(p, v, __ATOMIC_RELAXED, __HIP_MEMORY_SCOPE_AGENT); }
__device__ __forceinline__ unsigned xb_xcc_id() { return (unsigned)__builtin_amdgcn_s_getreg((3 << 11) | 20) & 0xFu; }
#define XB_SPIN(cond, bar) do { unsigned _sp = 0; while (cond) { __builtin_amdgcn_s_sleep(1); \
    if ((++_sp & 255u) == 0u) { if (xb_ld(&(bar)[XB_TMO])) break; if (_sp > XB_SPIN_CAP) { atomicAdd(&(bar)[XB_TMO], 1u); break; } } } } while (0)
struct XcdBarrier { unsigned* bar; unsigned x; volatile LAS unsigned* st; };
__device__ __forceinline__ XcdBarrier xcd_barrier_post(unsigned* bar, volatile LAS unsigned* st) {
    XcdBarrier b; b.bar = bar; b.x = xb_xcc_id(); b.st = st;
    if (threadIdx.x == 0) (void)xb_add(&bar[XB_XCNT(b.x)], 1u);
    return b;
}
__device__ __forceinline__ void xcd_barrier_complete(unsigned* bar, unsigned x, unsigned& nloc, unsigned& nx) {
    const unsigned G = gridDim.x * gridDim.y * gridDim.z;
    unsigned sum, cnt, mine, sp = 0u;
    for (;;) {
        sum = 0u; cnt = 0u; mine = 0u;
#pragma unroll
        for (unsigned j = 0; j < 16; ++j) { const unsigned c = xb_ld(&bar[XB_XCNT(j)]); sum += c; cnt += (c > 0u) ? 1u : 0u; mine = (j == x) ? c : mine; }
        if (sum == G) break;
        __builtin_amdgcn_s_sleep(1);
        if ((++sp & 255u) == 0u) { if (xb_ld(&bar[XB_TMO])) break; if (sp > XB_SPIN_CAP) { atomicAdd(&bar[XB_TMO], 1u); break; } }
    }
    nloc = mine > 0u ? mine : 1u; nx = cnt > 0u ? cnt : 1u;
}
__device__ __forceinline__ void xcd_barrier(const XcdBarrier& b) {
    asm volatile("s_waitcnt vmcnt(0)" ::: "memory");
    __syncthreads();
    if (threadIdx.x == 0) {
        unsigned* bar = b.bar;
        __builtin_amdgcn_s_waitcnt(0);
        unsigned nloc = b.st[0], nx = b.st[1];
        if (nloc == 0u) { xcd_barrier_complete(bar, b.x, nloc, nx); b.st[0] = nloc; b.st[1] = nx; }
        const unsigned old = xb_add(&bar[XB_XSUB(b.x)], 1u);
        const unsigned gen = old / nloc;
        if (old + 1u == (gen + 1u) * nloc) {
            __builtin_amdgcn_fence(__ATOMIC_RELEASE, "agent");
            asm volatile("s_waitcnt vmcnt(0)" ::: "memory");
            const unsigned og = xb_add(&bar[XB_TOP], 1u);
            const unsigned tg = og / nx;
            if (og + 1u == (tg + 1u) * nx) xb_add(&bar[XB_TOPGEN], 1u);
            else XB_SPIN(xb_ld(&bar[XB_TOPGEN]) == tg, bar);
            __builtin_amdgcn_fence(__ATOMIC_ACQUIRE, "agent");
            xb_add(&bar[XB_XGEN(b.x)], 1u);
            asm volatile("s_waitcnt vmcnt(0)" ::: "memory");
        } else {
            XB_SPIN(xb_ld(&bar[XB_XGEN(b.x)]) == gen, bar);
            __builtin_amdgcn_fence(__ATOMIC_ACQUIRE, "agent");
            asm volatile("s_waitcnt vmcnt(0)" ::: "memory");
        }
    }
    __syncthreads();
}

struct Params {
    const float* x_prompt; const float* x_sample; const float* g_mix_pre; const float* w_in; const float* g_q_lat; const float* w_q_up;
    const float* g_kv_lat; const float* w_kv_up; const float* na_rpb; const float* w_o; const float* g_mix_post; const float* g_ffn_pre;
    const float* w_ffn_up; const float* ffn_conv_w; const float* ffn_conv_b; const float* w_ffn_down; const float* g_ffn_post;
    float* out; unsigned char* ws;
};
constexpr int LDS_XCH = pg8::STAGE_BYTES + 1024, LDS_TOTAL = LDS_XCH + 8192;

__device__ __forceinline__ const float* xrow(const float* xp, const float* xs, int t) { return t < MP ? xp + (size_t)t * DM : xs + (size_t)(t - MP) * DM; }

__device__ __forceinline__ int srccol(int mode, int n) {
    if (mode == 0) {
        if (n < Z_KR) return n;
        if (n < Z_KR + 32) { const int jj = n - Z_KR; return Z_KR + (jj >> 1) + 16 * (jj & 1); }
        return n < ZP ? n : -1;
    } else if (mode == 1) {
        const int h = n / 96, d = n % 96;
        if (d < 64) return h * 96 + d;
        const int jj = d - 64; return h * 96 + 64 + (jj >> 1) + 16 * (jj & 1);
    } else if (mode == 2) {
        if (n < 512) return (n >> 6) * 128 + (n & 63);
        const int m2 = n - 512; return (m2 >> 6) * 128 + 64 + (m2 & 63);
    }
    if (mode == 4) { const int tile = n >> 8, w = n & 255; return (w < 128) ? (tile * 128 + w) : (DFF + tile * 128 + (w - 128)); }
    return n;
}
__device__ __forceinline__ void transpose_item(const float* __restrict__ W, int K, int Nsrc, bf16_t* __restrict__ WT, int Ndst, const float* __restrict__ kscale, int mode,
                                               LAS float* scr, int it, int lane) {
    const int nblk = Ndst / 32;
    {
        const int kb = it / nblk, nb = it % nblk, k0 = 64 * kb, n0 = 32 * nb;
        const int sc = srccol(mode, n0 + (lane & 31));
        float tv[32];
#pragma unroll
        for (int i = 0; i < 32; ++i) { const int kk = 2 * i + (lane >> 5); tv[i] = (sc >= 0) ? W[(size_t)(k0 + kk) * Nsrc + sc] : 0.f; }
        if (kscale) {
#pragma unroll
            for (int i = 0; i < 32; ++i) tv[i] *= kscale[k0 + 2 * i + (lane >> 5)]; }
#pragma unroll
        for (int i = 0; i < 32; ++i) scr[(2 * i + (lane >> 5)) * 33 + (lane & 31)] = tv[i];
        asm volatile("s_waitcnt lgkmcnt(0)" ::: "memory");
        const int c = lane & 7;
#pragma unroll
        for (int jx = 0; jx < 4; ++jx) { const int n = (lane >> 3) + 8 * jx; const LAS float* s = scr + (8 * c) * 33 + n;
            u32x4 o; o.x = cvtpk(s[0 * 33], s[1 * 33]); o.y = cvtpk(s[2 * 33], s[3 * 33]); o.z = cvtpk(s[4 * 33], s[5 * 33]); o.w = cvtpk(s[6 * 33], s[7 * 33]);
            *(u32x4*)(WT + (size_t)(n0 + n) * K + k0 + 8 * c) = o; }
        asm volatile("s_waitcnt lgkmcnt(0)" ::: "memory");
    }
}

__device__ const double ROPE_INV[16] = {1.0, 0.5623413251903491, 0.31622776601683794, 0.1778279410038923, 0.1, 0.05623413251903491, 0.031622776601683794, 0.01778279410038923,
                                        0.01, 0.005623413251903491, 0.0031622776601683794, 0.001778279410038923, 0.001, 0.0005623413251903491, 0.00031622776601683794, 0.0001778279410038923};


typedef const __attribute__((address_space(4))) Params* CParams;
__device__ __forceinline__ CParams kparams() { CParams q = (CParams)__builtin_amdgcn_kernarg_segment_ptr(); asm volatile("" : "+s"(q)); return q; }
__global__ void __launch_bounds__(512) fwd_kernel(Params p_unused) {
    extern __shared__ __attribute__((aligned(16))) unsigned char lds_raw[];
    LAS unsigned char* lds = (LAS unsigned char*)lds_raw;
    cg::grid_group grid = cg::this_grid();
    const int wave = __builtin_amdgcn_readfirstlane(threadIdx.x >> 6);
#define FRESH_TID() const int lane = lane_id_asm(), tid = wave * 64 + lane; (void)tid
    const int G = gridDim.x, bid = blockIdx.x;
    const int vcu = (G % 8 == 0) ? (bid % 8) * (G / 8) + bid / 8 : bid;
    const int gw = vcu * 8 + wave, NGW = G * 8;
#define PHASE_PTRS() const CParams pp = kparams(); unsigned char* const ws = pp->ws; (void)ws
#define Win_t ((bf16_t*)(ws + WS_WIN))
#define Wq_t ((bf16_t*)(ws + WS_WQ))
#define Wkv_t ((bf16_t*)(ws + WS_WKV))
#define Wo_t ((bf16_t*)(ws + WS_WO))
#define Wup_t ((bf16_t*)(ws + WS_WUP))
#define Wdn_t ((bf16_t*)(ws + WS_WDN))
#define cosT ((float*)(ws + WS_COS))
#define sinT ((float*)(ws + WS_SIN))
#define rstd_q ((float*)(ws + WS_RSQ))
#define rstd_kv ((float*)(ws + WS_RSKV))
#define R1 ((bf16_t*)(ws + WS_R1))
#define Z ((bf16_t*)(ws + WS_Z))
#define Qb ((bf16_t*)(ws + WS_Q))
#define Kb ((bf16_t*)(ws + WS_K))
#define Vb ((bf16_t*)(ws + WS_V))
#define MO ((bf16_t*)(ws + WS_MO))
#define ACT ((bf16_t*)(ws + WS_ACT))

    volatile LAS unsigned* bst = (volatile LAS unsigned*)(lds + pg8::STAGE_BYTES);
    {
        FRESH_TID(); PHASE_PTRS(); const float* xp_ = pp->x_prompt; const float* xs_ = pp->x_sample;
        if (tid < 2) bst[tid] = 0u;
        if (bid == 0) for (int i = tid; i < XCD_BAR_WORDS; i += 512) ((unsigned*)ws)[i] = 0u;
        LAS float* scr = (LAS float*)(lds + wave * 16384);
        {
            constexpr int I0 = 16 * 64, I1 = 4 * 24, I2 = 2 * 32, I3 = 16 * 32, I4 = 16 * 176, I5 = 44 * 32;
            for (int it = gw; it < I0 + I1 + I2 + I3 + I4 + I5; it += NGW) {
                int r = it;
                if (r < I0) { transpose_item(pp->w_in, 1024, 1952, Win_t, 2048, nullptr, 0, scr, r, lane); continue; } r -= I0;
                if (r < I1) { transpose_item(pp->w_q_up, 256, 768, Wq_t, 768, pp->g_q_lat, 1, scr, r, lane); continue; } r -= I1;
                if (r < I2) { transpose_item(pp->w_kv_up, 128, 1024, Wkv_t, 1024, pp->g_kv_lat, 2, scr, r, lane); continue; } r -= I2;
                if (r < I3) { transpose_item(pp->w_o, 1024, 1024, Wo_t, 1024, nullptr, 3, scr, r, lane); continue; } r -= I3;
                if (r < I4) { transpose_item(pp->w_ffn_up, 1024, NUP, Wup_t, NUP, nullptr, 4, scr, r, lane); continue; } r -= I4;
                transpose_item(pp->w_ffn_down, DFF, 1024, Wdn_t, 1024, nullptr, 3, scr, r, lane);
            }
        }
        for (int e = bid * 512 + tid; e < M; e += G * 512) { rstd_q[e] = 0.f; rstd_kv[e] = 0.f; }
        for (int e = bid * 512 + tid; e < SP * 16; e += G * 512) {
            const int s = e >> 4, i = e & 15;
            const double rev = (double)s * ROPE_INV[i] * 0.15915494309189535;
            const float fr = (float)(rev - floor(rev));
            cosT[e] = __builtin_amdgcn_cosf(fr); sinT[e] = __builtin_amdgcn_sinf(fr);
        }
        for (int t = gw; t < M; t += 2 * NGW) {
            f32x4 v[2][4]; float ss[2];
#pragma unroll
            for (int r = 0; r < 2; ++r) { const float* xr = xrow(xp_, xs_, t + r * NGW); ss[r] = 0.f;
#pragma unroll
                for (int j = 0; j < 4; ++j) v[r][j] = *(const f32x4*)(xr + 256 * j + 4 * lane); }
#pragma unroll
            for (int r = 0; r < 2; ++r) {
#pragma unroll
                for (int j = 0; j < 4; ++j) ss[r] += (v[r][j].x * v[r][j].x + v[r][j].y * v[r][j].y) + (v[r][j].z * v[r][j].z + v[r][j].w * v[r][j].w);
                const float rstd = rsqrtf(wave_sum(ss[r]) * (1.f / DM) + EPS);
#pragma unroll
                for (int j = 0; j < 4; ++j) { const f32x4 gg = *(const f32x4*)(pp->g_mix_pre + 256 * j + 4 * lane); const f32x4 o = v[r][j] * rstd * gg;
                    u32x2 w; w.x = cvtpk(o.x, o.y); w.y = cvtpk(o.z, o.w); *(u32x2*)(R1 + (size_t)(t + r * NGW) * DM + 256 * j + 4 * lane) = w; } }
        }
    }
    grid.sync();
    { PHASE_PTRS(); (void)xcd_barrier_post((unsigned*)ws, bst); }
#define GRID_BAR() do { XcdBarrier xb_; xb_.bar = (unsigned*)kparams()->ws; xb_.x = xb_xcc_id(); xb_.st = (volatile LAS unsigned*)(lds + pg8::STAGE_BYTES); xcd_barrier(xb_); } while (0)

    {
        PHASE_PTRS(); pg8::Gemm g{R1, Win_t, M, ZW, 1024, 1024, 1024}; pg8::StaticOrder S; S.init(M, ZW, G, bid);
        pg8::EpiZ E{Z, ZP, rstd_q, rstd_kv, Kb, cosT, sinT};
        pg8::gemm_phase(lds, g, S, E, wave);
    }
    GRID_BAR();
    {
        PHASE_PTRS(); pg8::Gemm g{Z, Wq_t, M, QW, 256, ZP, 256}; pg8::StaticOrder S; S.init(M, QW, G, bid);
        pg8::EpiQ E{Qb, rstd_q, cosT, sinT};
        pg8::gemm_phase(lds, g, S, E, wave);
    }
    {
        PHASE_PTRS(); pg8::Gemm g{Z + Z_CKV, Wkv_t, M, 1024, 128, ZP, 128}; pg8::StaticOrder S; S.init(M, 1024, G, bid);
        pg8::EpiKV E{Kb, Vb, rstd_kv};
        pg8::gemm_phase(lds, g, S, E, wave);
    }
    GRID_BAR();
    {
        FRESH_TID(); PHASE_PTRS();
        for (int it = 0;; ++it) {
            const int slot = it * G + vcu; if (slot >= 1536) break;
            int tokbase, h, qb, seq;
            if (slot < 1024) { const int i = slot >> 8, v = slot & 255, x = v >> 5, c = v & 31; const int pair = 2 * x + (i >> 1); tokbase = (pair >> 3) * SP; h = pair & 7; qb = (i & 1) * 32 + c; seq = SP; }
            else { const int s2 = slot - 1024, i = s2 >> 8, v = s2 & 255, x = v >> 5, c = v & 31; const int u = i * 32 + c, bh = 8 * x + (u >> 3); tokbase = MP + (bh >> 3) * SS; h = bh & 7; qb = u & 7; seq = SS; }
            mla2::attn_unit(Qb + (size_t)(tokbase + qb * 256) * QW + h * 96, Kb + (size_t)(h * NGT + (tokbase >> 6)) * 6144, Vb + (size_t)(h * NGT + (tokbase >> 6)) * 4096,
                           R1 + (size_t)(tokbase + qb * 256) * DM + h * 64, seq, (LAS char*)lds, wave);
        }
        LAS float* rpbl = (LAS float*)(lds + na::LDS_RPB);
        for (int i = tid; i < 8 * 465; i += 512) rpbl[i] = pp->na_rpb[i];
        __syncthreads();
        const int per = (1536 + G - 1) / G;
        LAS char* vbuf = (LAS char*)(lds + na::LDS_VB + wave * 2 * na::VBUF);
        for (int u = vcu * per; u < min(1536, (vcu + 1) * per); ++u) {
            const int grow = (u >> 2) * 2, j = u & 3; int tokbase, rows, r0;
            if (grow < 512) { tokbase = (grow >> 8) * SP; r0 = grow & 255; rows = 256; } else { const int g2 = grow - 512; tokbase = MP + (g2 >> 5) * SS; r0 = g2 & 31; rows = 32; }
            const int rs0 = min(max(r0 - 4, 0), rows - 8), rs1 = min(max(r0 - 3, 0), rows - 8);
            if (rs1 != rs0) na::unit2<1>(Z, R1, rpbl + wave * 465, vbuf, tokbase, rows, r0, j, wave);
            else na::unit2<0>(Z, R1, rpbl + wave * 465, vbuf, tokbase, rows, r0, j, wave);
        }
        __syncthreads();
    }
    GRID_BAR();
    {
        PHASE_PTRS(); pg8::Gemm g{R1, Wo_t, M, 1024, 1024, 1024, 1024}; pg8::StaticOrder S; S.init(M, 1024, G, bid);
        pg8::EpiStore E{MO, MOP};
        pg8::gemm_phase(lds, g, S, E, wave);
    }
    GRID_BAR();
    { FRESH_TID(); PHASE_PTRS(); const float* xp_ = pp->x_prompt; const float* xs_ = pp->x_sample;
    for (int t = gw; t < M; t += 2 * NGW) {
        f32x4 v[2][4], xv[2][4];
#pragma unroll
        for (int r = 0; r < 2; ++r) { const int tr = t + r * NGW; const float* xr = xrow(xp_, xs_, tr);
#pragma unroll
            for (int j = 0; j < 4; ++j) { const u32x2 w = *(const u32x2*)(MO + (size_t)tr * MOP + 256 * j + 4 * lane); v[r][j] = (f32x4){bflo(w.x), bfhi(w.x), bflo(w.y), bfhi(w.y)};
                xv[r][j] = *(const f32x4*)(xr + 256 * j + 4 * lane); } }
#pragma unroll
        for (int r = 0; r < 2; ++r) { const int tr = t + r * NGW; float ss = 0.f;
#pragma unroll
            for (int j = 0; j < 4; ++j) ss += (v[r][j].x * v[r][j].x + v[r][j].y * v[r][j].y) + (v[r][j].z * v[r][j].z + v[r][j].w * v[r][j].w);
            const float rstd = rsqrtf(wave_sum(ss) * (1.f / DM) + EPS);
            float s2 = 0.f;
#pragma unroll
            for (int j = 0; j < 4; ++j) { const f32x4 gg = *(const f32x4*)(pp->g_mix_post + 256 * j + 4 * lane);
                v[r][j] = xv[r][j] + v[r][j] * rstd * gg; s2 += (v[r][j].x * v[r][j].x + v[r][j].y * v[r][j].y) + (v[r][j].z * v[r][j].z + v[r][j].w * v[r][j].w);
                *(f32x4*)(pp->out + (size_t)tr * DM + 256 * j + 4 * lane) = v[r][j]; }
            const float rstd2 = rsqrtf(wave_sum(s2) * (1.f / DM) + EPS);
#pragma unroll
            for (int j = 0; j < 4; ++j) { const f32x4 gg = *(const f32x4*)(pp->g_ffn_pre + 256 * j + 4 * lane); const f32x4 o = v[r][j] * rstd2 * gg;
                u32x2 w; w.x = cvtpk(o.x, o.y); w.y = cvtpk(o.z, o.w); *(u32x2*)(R1 + (size_t)tr * DM + 256 * j + 4 * lane) = w; } }
    } }
    GRID_BAR();
    {
        PHASE_PTRS(); pg8::Gemm g{R1, Wup_t, M, NUP, 1024, 1024, 1024}; pg8::StaticOrder S; S.init_tiles(pg8::OVL_NM, NUP / 256, G, bid);
        pg8::EpiConv E{ACT, pp->ffn_conv_w, pp->ffn_conv_b, (LAS float*)(lds + LDS_XCH)};
        pg8::gemm_phase<pg8::EpiConv, true>(lds, g, S, E, wave);
    }
    GRID_BAR();
    {
        PHASE_PTRS(); pg8::Gemm g{ACT, Wdn_t, M, 1024, DFF, DFF, DFF}; pg8::StaticOrder S; S.init(M, 1024, G, bid);
        pg8::EpiStore E{MO, MOP};
        pg8::gemm_phase(lds, g, S, E, wave);
    }
    GRID_BAR();
    { FRESH_TID(); PHASE_PTRS();
    for (int t = gw; t < M; t += 2 * NGW) {
        f32x4 v[2][4], xv[2][4];
#pragma unroll
        for (int r = 0; r < 2; ++r) { const int tr = t + r * NGW;
#pragma unroll
            for (int j = 0; j < 4; ++j) { const u32x2 w = *(const u32x2*)(MO + (size_t)tr * MOP + 256 * j + 4 * lane); v[r][j] = (f32x4){bflo(w.x), bfhi(w.x), bflo(w.y), bfhi(w.y)};
                xv[r][j] = *(const f32x4*)(pp->out + (size_t)tr * DM + 256 * j + 4 * lane); } }
#pragma unroll
        for (int r = 0; r < 2; ++r) { const int tr = t + r * NGW; float ss = 0.f;
#pragma unroll
            for (int j = 0; j < 4; ++j) ss += (v[r][j].x * v[r][j].x + v[r][j].y * v[r][j].y) + (v[r][j].z * v[r][j].z + v[r][j].w * v[r][j].w);
            const float rstd = rsqrtf(wave_sum(ss) * (1.f / DM) + EPS);
#pragma unroll
            for (int j = 0; j < 4; ++j) { const f32x4 gg = *(const f32x4*)(pp->g_ffn_post + 256 * j + 4 * lane);
                *(f32x4*)(pp->out + (size_t)tr * DM + 256 * j + 4 * lane) = xv[r][j] + v[r][j] * rstd * gg; } }
    } }
}

extern "C" void kernel_launch(void* const* d_in, const int* in_sizes, int n_in, void* d_out, int out_size, void* d_ws, size_t ws_size, hipStream_t stream) {
    static int grid_blocks = 0;
    if (grid_blocks == 0) {
        if (n_in != 17 || in_sizes[0] != MP * DM || in_sizes[1] != MS * DM || out_size != M * DM || ws_size < WS_END) {
            fprintf(stderr, "kernel_launch: unexpected shapes (n_in %d, in0 %d, in1 %d, out %d, ws %zu)\n", n_in, n_in > 0 ? in_sizes[0] : -1, n_in > 1 ? in_sizes[1] : -1, out_size, ws_size);
            grid_blocks = -1; return; }
        int dev = 0, cus = 0, per_cu = 0;
        hipGetDevice(&dev);
        hipDeviceGetAttribute(&cus, hipDeviceAttributeMultiprocessorCount, dev);
        hipFuncSetAttribute((const void*)fwd_kernel, hipFuncAttributeMaxDynamicSharedMemorySize, LDS_TOTAL);
        hipOccupancyMaxActiveBlocksPerMultiprocessor(&per_cu, (const void*)fwd_kernel, 512, LDS_TOTAL);
        if (per_cu < 1) { fprintf(stderr, "kernel_launch: occupancy query returned %d\n", per_cu); per_cu = 1; }
        (void)hipGetLastError();
        grid_blocks = cus * 1;
    }
    if (grid_blocks < 0) return;
    Params p{};
    p.x_prompt = (const float*)d_in[0]; p.x_sample = (const float*)d_in[1]; p.g_mix_pre = (const float*)d_in[2]; p.w_in = (const float*)d_in[3];
    p.g_q_lat = (const float*)d_in[4]; p.w_q_up = (const float*)d_in[5]; p.g_kv_lat = (const float*)d_in[6]; p.w_kv_up = (const float*)d_in[7];
    p.na_rpb = (const float*)d_in[8]; p.w_o = (const float*)d_in[9]; p.g_mix_post = (const float*)d_in[10]; p.g_ffn_pre = (const float*)d_in[11];
    p.w_ffn_up = (const float*)d_in[12]; p.ffn_conv_w = (const float*)d_in[13]; p.ffn_conv_b = (const float*)d_in[14]; p.w_ffn_down = (const float*)d_in[15];
    p.g_ffn_post = (const float*)d_in[16]; p.out = (float*)d_out; p.ws = (unsigned char*)d_ws;
    void* args[] = {&p};
    hipError_t e = hipLaunchCooperativeKernel((const void*)fwd_kernel, dim3(grid_blocks), dim3(512), args, LDS_TOTAL, stream);
    if (e != hipSuccess) fprintf(stderr, "cooperative launch failed: %s (grid %d)\n", hipGetErrorString(e), grid_blocks);
}
```

```cpp
#include <hip/hip_runtime.h>
#include <hip/hip_cooperative_groups.h>
#include <cstdio>
#include <cstdint>
namespace cg = cooperative_groups;

#define LAS __attribute__((address_space(3)))
typedef unsigned short bf16_t;
typedef short bf16x8 __attribute__((ext_vector_type(8)));
typedef short s16x4 __attribute__((ext_vector_type(4)));
typedef float f32x2 __attribute__((ext_vector_type(2)));
typedef float f32x4 __attribute__((ext_vector_type(4)));
typedef float f32x16 __attribute__((ext_vector_type(16)));
typedef unsigned u32x2 __attribute__((ext_vector_type(2)));
typedef unsigned u32x4 __attribute__((ext_vector_type(4)));
typedef __bf16 bf16x2_t __attribute__((ext_vector_type(2)));

constexpr int MP = 32768, MS = 16384, M = MP + MS;
constexpr int DM = 1024, ZW = 2048, DFF = 2816, NUP = 2 * DFF;
constexpr int SP = 16384, SS = 2048;
constexpr int QW = 768, NGT = M / 64;
constexpr float EPS = 1e-6f;
constexpr float LOG2E = 1.4426950408889634f;
constexpr float QSCALE = 0.10206207261596575f * LOG2E;
constexpr int Z_CKV = 256, Z_KR = 384, Z_NQ = 416, Z_NK = 928, Z_NV = 1440;
constexpr int ZP = 1952;
constexpr int MOP = 1056;

constexpr size_t MiB = 1u << 20;
constexpr size_t WS_WIN = 1 * MiB;
constexpr size_t WS_WQ = 5 * MiB;
constexpr size_t WS_WKV = 5 * MiB + 512 * 1024;
constexpr size_t WS_WO = 6 * MiB;
constexpr size_t WS_WUP = 8 * MiB;
constexpr size_t WS_WDN = 19 * MiB;
constexpr size_t WS_COS = 25 * MiB, WS_SIN = 26 * MiB;
constexpr size_t WS_RSQ = 27 * MiB, WS_RSKV = 27 * MiB + 256 * 1024;
constexpr size_t WS_R1 = 32 * MiB;
constexpr size_t WS_Z = 128 * MiB;
constexpr size_t WS_Q = 320 * MiB, WS_K = 392 * MiB, WS_V = 464 * MiB;
constexpr size_t WS_MO = 128 * MiB;
constexpr size_t WS_ACT = 228 * MiB;
constexpr size_t WS_END = 512 * MiB;

__device__ __forceinline__ unsigned cvtpk(float lo, float hi) { f32x2 v = {lo, hi}; bf16x2_t b = __builtin_convertvector(v, bf16x2_t); return __builtin_bit_cast(unsigned, b); }
__device__ __forceinline__ float bflo(unsigned w) { return __uint_as_float(w << 16); }
__device__ __forceinline__ float bfhi(unsigned w) { return __uint_as_float(w & 0xffff0000u); }
__device__ __forceinline__ float wave_sum(float v) {
#pragma unroll
    for (int o = 1; o < 64; o <<= 1) v += __shfl_xor(v, o);
    return v;
}
__device__ __forceinline__ int lane_id_asm() { int l; asm volatile("v_mbcnt_lo_u32_b32 %0, -1, 0\n\tv_mbcnt_hi_u32_b32 %0, -1, %0" : "=v"(l)); return l; }
__device__ __forceinline__ int seqpos(int t) { return t < MP ? (t & (SP - 1)) : (t & (SS - 1)); }

__device__ __forceinline__ float gelu_tanh(float g) {
    const float u = g + 0.044715f * g * g * g;
    return g * __builtin_amdgcn_rcpf(1.f + __builtin_amdgcn_exp2f(-2.3022081983f * u));
}
__device__ __forceinline__ float dpp_prev(float v) { return __builtin_bit_cast(float, __builtin_amdgcn_mov_dpp(__builtin_bit_cast(int, v), 0x121, 0xF, 0xF, true)); }
__device__ __forceinline__ float dpp_next(float v) { return __builtin_bit_cast(float, __builtin_amdgcn_mov_dpp(__builtin_bit_cast(int, v), 0x12F, 0xF, 0xF, true)); }

template <bool EDGE> __device__ __forceinline__ void conv_col(float x0, float x1, float x2, float x3, float top, float bot, bool f0, bool f15, int sqb, int S,
                                         float w0, float w1, float w2, float b, float& h0, float& h1, float& h2, float& h3) {
    asm volatile("" : "+v"(x0), "+v"(x1), "+v"(x2), "+v"(x3));
    const float p0 = dpp_prev(x0), p1 = dpp_prev(x1), p2 = dpp_prev(x2), p3 = dpp_prev(x3);
    const float n0 = dpp_next(x0), n1 = dpp_next(x1), n2 = dpp_next(x2), n3 = dpp_next(x3);
    float u0 = f0 ? top : p0, u1 = f0 ? p0 : p1, u2 = f0 ? p1 : p2, u3 = f0 ? p2 : p3;
    float d0 = f15 ? n1 : n0, d1 = f15 ? n2 : n1, d2 = f15 ? n3 : n2, d3 = f15 ? bot : n3;
    if (EDGE) {
    const int sm = S - 1;
    u0 = ((sqb & sm) == 0) ? 0.f : u0; u1 = (((sqb + 16) & sm) == 0) ? 0.f : u1; u2 = (((sqb + 32) & sm) == 0) ? 0.f : u2; u3 = (((sqb + 48) & sm) == 0) ? 0.f : u3;
    d0 = ((sqb & sm) == sm) ? 0.f : d0; d1 = (((sqb + 16) & sm) == sm) ? 0.f : d1; d2 = (((sqb + 32) & sm) == sm) ? 0.f : d2; d3 = (((sqb + 48) & sm) == sm) ? 0.f : d3;
    }
    h0 = b + w0 * u0 + w1 * x0 + w2 * d0; h1 = b + w0 * u1 + w1 * x1 + w2 * d1; h2 = b + w0 * u2 + w1 * x2 + w2 * d2; h3 = b + w0 * u3 + w1 * x3 + w2 * d3;
}

template <bool EDGE> __device__ __forceinline__ void conv_rows(float x0, float x1, float x2, float x3, float top, float bot, bool f0, bool f15, int sqb, int S,
                                                          float w0, float w1, float w2, float b, float& h0, float& h1, float& h2, float& h3) {
    asm volatile("" : "+v"(x0), "+v"(x1), "+v"(x2), "+v"(x3));
    const float p3 = dpp_prev(x3), n0 = dpp_next(x0);
    float u0 = f0 ? top : p3, u1 = x0, u2 = x1, u3 = x2;
    float d0 = x1, d1 = x2, d2 = x3, d3 = f15 ? bot : n0;
    if (EDGE) {
        const int sm = S - 1;
        u0 = ((sqb & sm) == 0) ? 0.f : u0; u1 = (((sqb + 1) & sm) == 0) ? 0.f : u1; u2 = (((sqb + 2) & sm) == 0) ? 0.f : u2; u3 = (((sqb + 3) & sm) == 0) ? 0.f : u3;
        d0 = ((sqb & sm) == sm) ? 0.f : d0; d1 = (((sqb + 1) & sm) == sm) ? 0.f : d1; d2 = (((sqb + 2) & sm) == sm) ? 0.f : d2; d3 = (((sqb + 3) & sm) == sm) ? 0.f : d3;
    }
    h0 = b + w0 * u0 + w1 * x0 + w2 * d0; h1 = b + w0 * u1 + w1 * x1 + w2 * d1; h2 = b + w0 * u2 + w1 * x2 + w2 * d2; h3 = b + w0 * u3 + w1 * x3 + w2 * d3;
}

namespace pg8 {
constexpr int BM = 256, BK = 64, HALF = 128, HTB = HALF * BK * 2, STAGE_BYTES = 8 * HTB, NXCD = 8, WGM = 8;
__device__ __forceinline__ int lds_byte(int r, int c) { const int st = (r >> 4) * 2 + (c >> 5), rr = r & 15, cc = c & 31, ob = rr * 64 + cc * 2; return st * 1024 + (ob ^ (((ob >> 9) & 1) << 5)); }
__device__ __forceinline__ void stage_rc(int b, int& R, int& C) { const int st = b / 1024, sb = b % 1024, swz = sb ^ (((sb >> 9) & 1) << 5); R = (st >> 1) * 16 + swz / 64; C = (st & 1) * 32 + (swz % 64) / 2; }
__device__ __forceinline__ int perm32(int rho) { const int n = rho >> 4, i = rho & 15; return 8 * (i >> 2) + 4 * n + (i & 3); }
struct Unit { int pm, pn; };
constexpr int OVL_TP = 65, OVL_NM = 3 * OVL_TP;
__device__ __forceinline__ void ovl_decode(int pm, int& regbase, int& t, int& S) {
    const int q = pm / OVL_TP; regbase = q * SP; t = pm - OVL_TP * q; S = (q < 2) ? SP : SS;
}
template <bool OVL> __device__ __forceinline__ long tile_row0(int pm) {
    if (!OVL) return (long)pm * 256;
    int seqbase, t, S; ovl_decode(pm, seqbase, t, S); return (long)seqbase + 254 * t - 1;
}
struct Gemm { const bf16_t* A; const bf16_t* Bt; int M, N, K, lda, ldb; };
struct StaticOrder {
    int nM, nN, nwg, G, c;
    __device__ void init(int M_, int N_, int G_, int c_) { nM = M_ / BM; nN = N_ / BM; nwg = nM * nN; G = G_; c = c_; }
    __device__ void init_tiles(int nM_, int nN_, int G_, int c_) { nM = nM_; nN = nN_; nwg = nM * nN; G = G_; c = c_; }
    __device__ bool next(int i, Unit& u) const {
        const long L = (long)i * G + c; if (L >= nwg) return false;
        int wgid = (int)L; { const int q = nwg / NXCD, r = nwg % NXCD, xcd = wgid % NXCD, off = wgid / NXCD; wgid = (xcd < r ? xcd * (q + 1) : r * (q + 1) + (xcd - r) * q) + off; }
        const int nig = WGM * nN, gid = wgid / nig, fm = gid * WGM, gsz = (nM - fm) < WGM ? (nM - fm) : WGM;
        u.pm = fm + ((wgid % nig) % gsz); u.pn = (wgid % nig) / gsz; return true;
    }
};
typedef f32x4 Acc[2][2][4][2];

struct EpiStore {
    bf16_t* O; int ldc;
    __device__ __forceinline__ void operator()(const Acc& acc, const Unit& u, int wr, int wc, int fr, int fq) const {
        const int row0 = u.pm * BM + wr * 64 + fr, col0 = u.pn * BM + wc * 32 + 8 * fq;
#pragma unroll
        for (int ai = 0; ai < 2; ++ai)
#pragma unroll
            for (int m = 0; m < 4; ++m) { bf16_t* rowp = O + (size_t)(row0 + ai * HALF + m * 16) * ldc + col0;
#pragma unroll
                for (int bj = 0; bj < 2; ++bj) { const f32x4 v0 = acc[ai][bj][m][0], v1 = acc[ai][bj][m][1];
                    u32x4 w; w.x = cvtpk(v0[0], v0[1]); w.y = cvtpk(v0[2], v0[3]); w.z = cvtpk(v1[0], v1[1]); w.w = cvtpk(v1[2], v1[3]);
                    *(u32x4*)(rowp + bj * HALF) = w; } }
    }
};
struct EpiZ {
    bf16_t* O; int ldc; float* ssq_q; float* ssq_kv; bf16_t* Kt; const float* cosT; const float* sinT;
    __device__ __forceinline__ void operator()(const Acc& acc, const Unit& u, int wr, int wc, int fr, int fq) const {
        const int row0 = u.pm * BM + wr * 64 + fr, col0 = u.pn * BM + wc * 32 + 8 * fq;
#pragma unroll
        for (int ai = 0; ai < 2; ++ai)
#pragma unroll
            for (int m = 0; m < 4; ++m) { const int row = row0 + ai * HALF + m * 16; bf16_t* rowp = O + (size_t)row * ldc + col0;
#pragma unroll
                for (int bj = 0; bj < 2; ++bj) { const f32x4 v0 = acc[ai][bj][m][0], v1 = acc[ai][bj][m][1];
                    u32x4 w; w.x = cvtpk(v0[0], v0[1]); w.y = cvtpk(v0[2], v0[3]); w.z = cvtpk(v1[0], v1[1]); w.w = cvtpk(v1[2], v1[3]);
                    if (col0 + bj * HALF < ZP) *(u32x4*)(rowp + bj * HALF) = w; }
                if (u.pn <= 1) {
                    float sq = 0.f;
#pragma unroll
                    for (int bj = 0; bj < 2; ++bj) { if (bj == 1 && u.pn == 1) continue;
#pragma unroll
                        for (int n = 0; n < 2; ++n) { const f32x4 v = acc[ai][bj][m][n]; sq += (v[0] * v[0] + v[1] * v[1]) + (v[2] * v[2] + v[3] * v[3]); } }
                    sq += __shfl_xor(sq, 16); sq += __shfl_xor(sq, 32);
                    if (fq == 0) atomicAdd((u.pn == 0 ? ssq_q : ssq_kv) + row, sq);
                    if (u.pn == 1 && wc == 0) {
                        const int sp_ = seqpos(row); const f32x4 c = *(const f32x4*)(cosT + sp_ * 16 + 4 * fq), sn = *(const f32x4*)(sinT + sp_ * 16 + 4 * fq);
                        const f32x4 a = acc[ai][1][m][0], b = acc[ai][1][m][1];
                        u32x4 w; w.x = cvtpk(a[0] * c[0] - a[1] * sn[0], a[0] * sn[0] + a[1] * c[0]); w.y = cvtpk(a[2] * c[1] - a[3] * sn[1], a[2] * sn[1] + a[3] * c[1]);
                        w.z = cvtpk(b[0] * c[2] - b[1] * sn[2], b[0] * sn[2] + b[1] * c[2]); w.w = cvtpk(b[2] * c[3] - b[3] * sn[3], b[2] * sn[3] + b[3] * c[3]);
                        const int gt = row >> 6, r = row & 63;
#pragma unroll
                        for (int h = 0; h < 8; ++h) *(u32x4*)(Kt + ((size_t)((h * NGT + gt) * 12 + 8 + fq)) * 512 + r * 8) = w; }
                }
            }
    }
};
struct EpiQ {
    bf16_t* Q; const float* rstd; const float* cosT; const float* sinT;
    __device__ __forceinline__ void operator()(const Acc& acc, const Unit& u, int wr, int wc, int fr, int fq) const {
        const int row0 = u.pm * BM + wr * 64 + fr, col0 = u.pn * BM + wc * 32 + 8 * fq;
#pragma unroll
        for (int ai = 0; ai < 2; ++ai)
#pragma unroll
            for (int m = 0; m < 4; ++m) { const int row = row0 + ai * HALF + m * 16; const float rs = rsqrtf(rstd[row] * (1.f / 256.f) + EPS) * QSCALE; const int s = seqpos(row);
#pragma unroll
                for (int bj = 0; bj < 2; ++bj) { const int col = col0 + bj * HALF; const int d = col % 96;
                    f32x4 v0 = acc[ai][bj][m][0] * rs, v1 = acc[ai][bj][m][1] * rs;
                    if (d >= 64) { const int i0 = (d - 64) >> 1; const f32x4 c = *(const f32x4*)(cosT + s * 16 + i0), sn = *(const f32x4*)(sinT + s * 16 + i0);
                        const f32x4 a = v0, b = v1;
                        v0[0] = a[0] * c[0] - a[1] * sn[0]; v0[1] = a[0] * sn[0] + a[1] * c[0]; v0[2] = a[2] * c[1] - a[3] * sn[1]; v0[3] = a[2] * sn[1] + a[3] * c[1];
                        v1[0] = b[0] * c[2] - b[1] * sn[2]; v1[1] = b[0] * sn[2] + b[1] * c[2]; v1[2] = b[2] * c[3] - b[3] * sn[3]; v1[3] = b[2] * sn[3] + b[3] * c[3]; }
                    u32x4 w; w.x = cvtpk(v0[0], v0[1]); w.y = cvtpk(v0[2], v0[3]); w.z = cvtpk(v1[0], v1[1]); w.w = cvtpk(v1[2], v1[3]);
                    *(u32x4*)(Q + (size_t)row * QW + col) = w; } }
    }
};
struct EpiKV {
    bf16_t* Kt; bf16_t* Vt; const float* rstd;
    __device__ __forceinline__ void operator()(const Acc& acc, const Unit& u, int wr, int wc, int fr, int fq) const {
        const int row0 = u.pm * BM + wr * 64 + fr, col0 = u.pn * BM + wc * 32 + 8 * fq;
#pragma unroll
        for (int ai = 0; ai < 2; ++ai)
#pragma unroll
            for (int m = 0; m < 4; ++m) { const int row = row0 + ai * HALF + m * 16; const float rs = rsqrtf(rstd[row] * (1.f / 128.f) + EPS); const int gt = row >> 6, r = row & 63;
#pragma unroll
                for (int bj = 0; bj < 2; ++bj) { const int col = col0 + bj * HALF; const f32x4 v0 = acc[ai][bj][m][0] * rs, v1 = acc[ai][bj][m][1] * rs;
                    u32x4 w; w.x = cvtpk(v0[0], v0[1]); w.y = cvtpk(v0[2], v0[3]); w.z = cvtpk(v1[0], v1[1]); w.w = cvtpk(v1[2], v1[3]);
                    bf16_t* dst;
                    if (col < 512) { const int h = col >> 6, d = col & 63; dst = Kt + ((size_t)((h * NGT + gt) * 12 + (d >> 3))) * 512 + r * 8; }
                    else { const int v = col - 512, h = v >> 6, d = v & 63; dst = Vt + ((size_t)((h * NGT + gt) * 8 + (d >> 5) * 4 + (r >> 4))) * 512 + (r & 15) * 32 + (d & 31); }
                    *(u32x4*)dst = w; } }
    }
};

struct EpiConv {
    bf16_t* ACT; const float* cw; const float* cb; LAS float* xch;
#define LOADT(k, b_) { const float* wp_ = cw + chan0 + (k); tw[b_][0] = wp_[0]; tw[b_][1] = wp_[NUP]; tw[b_][2] = wp_[2 * NUP]; tw[b_][3] = cb[chan0 + (k)]; \
                       tw[b_][4] = wp_[DFF]; tw[b_][5] = wp_[NUP + DFF]; tw[b_][6] = wp_[2 * NUP + DFF]; tw[b_][7] = cb[DFF + chan0 + (k)]; }
    template <bool EDGE> __device__ __forceinline__ void compute(Acc& acc, int chan0, int colb, int s0, int S, int wr, int fr) const {
        float tw[2][8];
        LOADT(0, 0)
        const bool f0 = (fr == 0), f15 = (fr == 15);
#pragma unroll
        for (int n = 0; n < 2; ++n)
#pragma unroll
            for (int c = 0; c < 4; ++c) {
                constexpr int dummy_ = 0; (void)dummy_;
                const int k_ = 4 * n + c;
                if (k_ + 1 < 8) LOADT(k_ + 1, (k_ + 1) & 1)
                const float wg0 = tw[k_ & 1][0], wg1 = tw[k_ & 1][1], wg2 = tw[k_ & 1][2], bg = tw[k_ & 1][3], wu0 = tw[k_ & 1][4], wu1 = tw[k_ & 1][5], wu2 = tw[k_ & 1][6], bu = tw[k_ & 1][7];
#pragma unroll
                for (int ai = 0; ai < 2; ++ai) { const int blk = 2 * ai + wr;
                    const int sqb = s0 + 64 * blk + 4 * fr;
                    float gt = 0.f, ut = 0.f, gb = 0.f, ub = 0.f;
                    if (blk > 0) { gt = xch[((blk - 1) * 2 + 1) * 256 + colb + 4 * n + c]; ut = xch[((blk - 1) * 2 + 1) * 256 + 128 + colb + 4 * n + c]; }
                    if (blk < 3) { gb = xch[((blk + 1) * 2 + 0) * 256 + colb + 4 * n + c]; ub = xch[((blk + 1) * 2 + 0) * 256 + 128 + colb + 4 * n + c]; }
                    float hg0, hg1, hg2, hg3, hu0, hu1, hu2, hu3;
                    conv_rows<EDGE>(acc[ai][0][0][n][c], acc[ai][0][1][n][c], acc[ai][0][2][n][c], acc[ai][0][3][n][c], gt, gb, f0, f15, sqb, S, wg0, wg1, wg2, bg, hg0, hg1, hg2, hg3);
                    conv_rows<EDGE>(acc[ai][1][0][n][c], acc[ai][1][1][n][c], acc[ai][1][2][n][c], acc[ai][1][3][n][c], ut, ub, f0, f15, sqb, S, wu0, wu1, wu2, bu, hu0, hu1, hu2, hu3);
                    float r0 = gelu_tanh(hg0) * hu0, r1 = gelu_tanh(hg1) * hu1, r2 = gelu_tanh(hg2) * hu2, r3 = gelu_tanh(hg3) * hu3;
                    asm volatile("" : "+v"(r0), "+v"(r1), "+v"(r2), "+v"(r3));
                    acc[ai][0][0][n][c] = r0; acc[ai][0][1][n][c] = r1; acc[ai][0][2][n][c] = r2; acc[ai][0][3][n][c] = r3;
                    __builtin_amdgcn_sched_barrier(0);
                }
            }
    }
    __device__ __forceinline__ void operator()(Acc& acc, const Unit& u, int wr, int wc, int fr, int fq) const {
        int seqbase, t, S; ovl_decode(u.pm, seqbase, t, S);
        const int s0 = 254 * t - 1;
        const int colb = wc * 32 + 8 * fq;
        const int chan0 = u.pn * 128 + colb;
#pragma unroll
        for (int ai = 0; ai < 2; ++ai) { const int blk = 2 * ai + wr;
            if (fr == 0) {
#pragma unroll
                for (int bj = 0; bj < 2; ++bj)
#pragma unroll
                    for (int n = 0; n < 2; ++n) *(LAS f32x4*)(xch + (blk * 2 + 0) * 256 + bj * 128 + colb + 4 * n) = acc[ai][bj][0][n]; }
            if (fr == 15) {
#pragma unroll
                for (int bj = 0; bj < 2; ++bj)
#pragma unroll
                    for (int n = 0; n < 2; ++n) *(LAS f32x4*)(xch + (blk * 2 + 1) * 256 + bj * 128 + colb + 4 * n) = acc[ai][bj][3][n]; } }
        asm volatile("s_waitcnt lgkmcnt(0)\n\ts_barrier" ::: "memory");
        if ((s0 < 0) || ((s0 & (S - 1)) > S - 258)) compute<true>(acc, chan0, colb, s0, S, wr, fr); else compute<false>(acc, chan0, colb, s0, S, wr, fr);
#undef LOADT
#pragma unroll
        for (int ai = 0; ai < 2; ++ai) { const int blk = 2 * ai + wr;
#pragma unroll
            for (int m = 0; m < 4; ++m) { const int R = 64 * blk + 4 * fr + m, sq = s0 + R;
                if (R >= 1 && R <= 254 && sq < SP) { const f32x4 v0 = acc[ai][0][m][0], v1 = acc[ai][0][m][1];
                    u32x4 w; w.x = cvtpk(v0[0], v0[1]); w.y = cvtpk(v0[2], v0[3]); w.z = cvtpk(v1[0], v1[1]); w.w = cvtpk(v1[2], v1[3]);
                    *(u32x4*)(ACT + (size_t)(seqbase + sq) * DFF + chan0) = w; } }
        }
    }
};

template <class Epi, bool OVL = false>
__device__ __forceinline__ void gemm_phase(LAS unsigned char* lds, const Gemm g, const StaticOrder& S, const Epi& E, const int wid) {
    const int lane = lane_id_asm(), tid = wid * 64 + lane;
    const int wr = wid >> 2, wc = wid & 3, fr = lane & 15, fq = lane >> 4;
    const int nt = g.K / BK;
    const char* gA = (const char*)g.A; const char* gB = (const char*)g.Bt;
    asm volatile("" : "+s"(gA), "+s"(gB));
    unsigned voffA[2], voffB[2];
#pragma unroll
    for (int i = 0; i < 2; ++i) { int R, C; stage_rc(tid * 16 + i * 8192, R, C); const int Rb = (R & ~31) + perm32(R & 31);
        const int Ra = OVL ? ((R & 64) + 4 * (R & 15) + ((R >> 4) & 3)) : R;
        voffA[i] = (unsigned)(Ra * g.lda + C) * 2u; voffB[i] = (unsigned)(Rb * g.ldb + C) * 2u; }
    const size_t kstep = (size_t)(BK * 2);
    const size_t hstepA = (size_t)HALF * g.lda * 2, hstepB = (size_t)HALF * g.ldb * 2;
    const size_t tstepB = 2 * hstepB;
    const unsigned ldsw = (unsigned)wid * 1024u;
    const int aoff = lds_byte(wr * 64 + fr, fq * 8), boff = lds_byte(wc * 32 + fr, fq * 8);
#define PG8_SA(b, h) (((b) * 2 + (h)) * HTB)
#define PG8_SB(b, h) ((4 + (b) * 2 + (h)) * HTB)
#define PG8_STAGE(bufoff, gbase, voff) do { _Pragma("unroll") for (int _i = 0; _i < 2; ++_i) \
        __builtin_amdgcn_global_load_lds((const unsigned*)((const char*)(gbase) + (voff)[_i]), (LAS unsigned*)(lds + (bufoff) + ldsw + _i * 8192), 16, 0, 0); } while (0)
#define PG8_LDA(dst, b, h) do { _Pragma("unroll") for (int m = 0; m < 4; ++m) _Pragma("unroll") for (int k = 0; k < 2; ++k) dst[m][k] = *(const LAS bf16x8*)(lds + PG8_SA(b, h) + aoff + m * 2048 + k * 1024); } while (0)
#define PG8_LDB(dst, b, h) do { _Pragma("unroll") for (int n = 0; n < 2; ++n) _Pragma("unroll") for (int k = 0; k < 2; ++k) dst[n][k] = *(const LAS bf16x8*)(lds + PG8_SB(b, h) + boff + n * 2048 + k * 1024); } while (0)
#define PG8_MMA(ai, bj, At, Bt) do { __builtin_amdgcn_s_setprio(1); _Pragma("unroll") for (int m = 0; m < 4; ++m) _Pragma("unroll") for (int n = 0; n < 2; ++n) _Pragma("unroll") for (int k = 0; k < 2; ++k) \
        acc[ai][bj][m][n] = __builtin_amdgcn_mfma_f32_16x16x32_bf16(Bt[n][k], At[m][k], acc[ai][bj][m][n], 0, 0, 0); __builtin_amdgcn_s_setprio(0); } while (0)
#define PG8_WAIT_V(n) asm volatile("s_waitcnt vmcnt(" #n ")" ::: "memory")
#define PG8_WAIT_L(n) asm volatile("s_waitcnt lgkmcnt(" #n ")" ::: "memory")
#define PG8_BAR __builtin_amdgcn_s_barrier()
#define PG8_SCHED __builtin_amdgcn_sched_barrier(0)
    Unit cur, nxt; int ui = 0;
    if (!S.next(0, cur)) return;
    Acc acc;
#pragma unroll
    for (int a = 0; a < 2; ++a)
#pragma unroll
        for (int b = 0; b < 2; ++b)
#pragma unroll
            for (int m = 0; m < 4; ++m)
#pragma unroll
                for (int n = 0; n < 2; ++n) acc[a][b][m][n] = (f32x4){0.f, 0.f, 0.f, 0.f};
    bf16x8 At[4][2], B0[2][2], B1[2][2];
    const long rowB = (long)g.lda * 2; const char* cA = gA + tile_row0<OVL>(cur.pm) * rowB; const char* cB = gB + (size_t)cur.pn * tstepB;
    PG8_STAGE(PG8_SB(0, 0), cB, voffB); PG8_STAGE(PG8_SB(0, 1), cB + hstepB, voffB); PG8_STAGE(PG8_SA(0, 0), cA, voffA); PG8_STAGE(PG8_SA(0, 1), cA + hstepA, voffA);
    if (wr == 1) PG8_BAR;
    PG8_WAIT_V(2); PG8_BAR;
    PG8_STAGE(PG8_SB(1, 0), cB + kstep, voffB); PG8_STAGE(PG8_SA(1, 0), cA + kstep, voffA); PG8_STAGE(PG8_SB(1, 1), cB + hstepB + kstep, voffB);
    PG8_WAIT_V(6); PG8_BAR;
    for (;;) {
        const bool has_next = S.next(ui + 1, nxt);
        const char* nA = has_next ? gA + tile_row0<OVL>(nxt.pm) * rowB : cA; const char* nB = has_next ? gB + (size_t)nxt.pn * tstepB : cB;
        for (int t = 0; t < nt; t += 2) {
            const bool last = (t == nt - 2);
            const char* a1 = cA + (size_t)(t + 1) * kstep;
            const char* a2 = last ? nA : cA + (size_t)(t + 2) * kstep; const char* b2 = last ? nB : cB + (size_t)(t + 2) * kstep;
            const char* a3 = a2 + kstep; const char* b3 = b2 + kstep;
            PG8_LDB(B0, 0, 0); PG8_LDB(B1, 0, 1); PG8_SCHED; PG8_LDA(At, 0, 0); PG8_STAGE(PG8_SA(1, 1), a1 + hstepA, voffA);
            PG8_WAIT_V(8); PG8_WAIT_L(0); PG8_BAR; PG8_MMA(0, 0, At, B0); PG8_MMA(0, 1, At, B1); PG8_BAR; PG8_SCHED;
            PG8_LDA(At, 0, 1); PG8_STAGE(PG8_SB(0, 0), b2, voffB); PG8_STAGE(PG8_SB(0, 1), b2 + hstepB, voffB); PG8_STAGE(PG8_SA(0, 0), a2, voffA);
            PG8_WAIT_V(8); PG8_WAIT_L(0); PG8_BAR; PG8_MMA(1, 0, At, B0); PG8_MMA(1, 1, At, B1); PG8_BAR; PG8_SCHED;
            PG8_LDB(B0, 1, 0); PG8_LDB(B1, 1, 1); PG8_SCHED; PG8_LDA(At, 1, 0); PG8_STAGE(PG8_SA(0, 1), a2 + hstepA, voffA);
            PG8_WAIT_V(8); PG8_WAIT_L(0); PG8_BAR; PG8_MMA(0, 0, At, B0); PG8_MMA(0, 1, At, B1); PG8_BAR; PG8_SCHED;
            PG8_LDA(At, 1, 1); PG8_STAGE(PG8_SB(1, 0), b3, voffB); PG8_STAGE(PG8_SB(1, 1), b3 + hstepB, voffB); PG8_STAGE(PG8_SA(1, 0), a3, voffA);
            PG8_WAIT_V(8); PG8_WAIT_L(0); PG8_BAR; PG8_MMA(1, 0, At, B0); PG8_MMA(1, 1, At, B1); PG8_BAR; PG8_SCHED;
        }
        if (wr == 0) PG8_BAR;
        { const int l2 = lane_id_asm(); E(acc, cur, wr, wc, l2 & 15, l2 >> 4); }
        if (!has_next) break;
#pragma unroll
        for (int a = 0; a < 2; ++a)
#pragma unroll
            for (int b = 0; b < 2; ++b)
#pragma unroll
                for (int m = 0; m < 4; ++m)
#pragma unroll
                    for (int n = 0; n < 2; ++n) acc[a][b][m][n] = (f32x4){0.f, 0.f, 0.f, 0.f};
        cur = nxt; cA = nA; cB = nB; ++ui;
        if (wr == 1) PG8_BAR;
    }
    PG8_WAIT_V(0);
    PG8_BAR;
#undef PG8_SA
#undef PG8_SB
#undef PG8_STAGE
#undef PG8_LDA
#undef PG8_LDB
#undef PG8_MMA
#undef PG8_WAIT_V
#undef PG8_WAIT_L
#undef PG8_BAR
#undef PG8_SCHED
}
}

namespace mla2 {
constexpr int QBLK = 32, KVBLK = 64, NSLOT = 3, KSLOT = 12288, VSLOT = 8192;
constexpr int LDS_K = 0, LDS_V = NSLOT * KSLOT, LDS_WS = LDS_V + NSLOT * VSLOT, LDS_OST = LDS_WS + 8 * 64 * 4, LDS_BYTES = LDS_OST + 8 * 4096;
constexpr int THRL = 8;
typedef const LAS char* lds_cptr;
typedef short v4i16_t __attribute__((ext_vector_type(4)));
#define SBAR() __builtin_amdgcn_sched_barrier(0)
__device__ __forceinline__ int crow(int r, int hi) { return (r & 3) + 8 * (r >> 2) + 4 * hi; }
__device__ __forceinline__ void glds16(const void* gsrc, unsigned lds_dst) { unsigned keep;
    asm volatile("s_mov_b32 %0, m0\n\ts_mov_b32 m0, %2\n\ts_nop 0\n\tglobal_load_lds_dwordx4 %1, off\n\ts_mov_b32 m0, %0" : "=&s"(keep) : "v"(gsrc), "s"(lds_dst) : "memory"); }
__device__ __forceinline__ s16x4 vtr(lds_cptr p) { return __builtin_bit_cast(s16x4, __builtin_amdgcn_ds_read_tr16_b64_v4i16((LAS v4i16_t*)p)); }
__device__ __forceinline__ void kload2(bf16x8* kf, lds_cptr kp, int j) { kf[2 * j] = *(const LAS bf16x8*)(kp + j * 2048); kf[2 * j + 1] = *(const LAS bf16x8*)(kp + j * 2048 + 512); }
#define MX3(a, b, c) __builtin_fmaxf(__builtin_fmaxf((a), (b)), (c))
__device__ __forceinline__ float rowmax(const f32x16& p0, const f32x16& p1) {
    float a = MX3(p0[0], p0[1], p1[0]), b = MX3(p0[2], p0[3], p1[1]); a = MX3(a, p1[2], p1[3]);
#pragma unroll
    for (int r = 4; r < 16; r += 4) { a = MX3(a, p0[r], p0[r + 1]); b = MX3(b, p0[r + 2], p0[r + 3]); a = MX3(a, p1[r], p1[r + 1]); b = MX3(b, p1[r + 2], p1[r + 3]); }
    float rm = __builtin_fmaxf(a, b);
    auto rr = __builtin_amdgcn_permlane32_swap(__float_as_uint(rm), __float_as_uint(rm), false, false);
    return __builtin_fmaxf(__uint_as_float(rr[0]), __uint_as_float(rr[1]));
}
#define WAITB(NK, NV) do { if (kw) asm volatile("s_waitcnt vmcnt(" #NK ") lgkmcnt(0)\n\ts_barrier" ::: "memory"); else asm volatile("s_waitcnt vmcnt(" #NV ") lgkmcnt(0)\n\ts_barrier" ::: "memory"); } while (0)

__device__ __forceinline__ void attn_unit(const bf16_t* __restrict__ Qb, const bf16_t* __restrict__ Kh, const bf16_t* __restrict__ Vh, bf16_t* __restrict__ Ob, int seq, LAS char* shm, const int wid) {
    const int lane = lane_id_asm(), r32 = lane & 31, hi = lane >> 5;
    const bool kw = wid < 4;
    const unsigned lds0 = (unsigned)(size_t)shm;
    LAS float* wsf = (LAS float*)(shm + LDS_WS) + wid * 64;
    const bf16_t* ksrc = Kh + wid * 512 + lane * 8;
    const int vi0 = 2 * (wid & 3);
    const bf16_t* vsrc0 = Vh + vi0 * 512 + lane * 8;
    const bf16_t* vsrc1 = vsrc0 + 512;
    const unsigned kdst = lds0 + LDS_K + wid * 1024, vdst = lds0 + LDS_V + vi0 * 1024;
#define DMA_K(t, si) do { if (kw) { const bf16_t* s_ = ksrc + (long)(t) * 6144; const unsigned d_ = (unsigned)__builtin_amdgcn_readfirstlane(kdst + (si) * KSLOT); \
        glds16(s_, d_); glds16(s_ + 2048, d_ + 4096); glds16(s_ + 4096, d_ + 8192); } } while (0)
#define DMA_V(t, si) do { if (!kw) { const unsigned d_ = (unsigned)__builtin_amdgcn_readfirstlane(vdst + (si) * VSLOT); \
        glds16(vsrc0 + (long)(t) * 4096, d_); glds16(vsrc1 + (long)(t) * 4096, d_ + 1024); } } while (0)
    const lds_cptr shm3 = (lds_cptr)shm;
    const lds_cptr kp0 = shm3 + LDS_K + hi * 1024 + r32 * 16;
    const lds_cptr vp0 = shm3 + LDS_V + ((lane >> 4) & 1) * 32 + (lane & 3) * 8 + (4 * hi + ((lane & 15) >> 2)) * 64;
    const int NT = seq / KVBLK;
    bf16x8 qr[6];
    { const bf16_t* Qw = Qb + (long)(wid * QBLK + r32) * QW + hi * 8;
#pragma unroll
      for (int d0 = 0; d0 < 6; ++d0) qr[d0] = *(const bf16x8*)(Qw + d0 * 16); }
    asm volatile("s_waitcnt vmcnt(0)" ::: "memory");
    DMA_K(0, 0); DMA_V(0, 0); DMA_K(1, 1); DMA_K(2, 2);
    float mhat = 0.f, l_reg = 0.f; f32x16 o[2]; o[0] = f32x16{}; o[1] = f32x16{}; f32x16 negm = f32x16{}; asm volatile("" : "+v"(negm));
    f32x16 pA0, pA1, pB0, pB1; bf16x8 kf[12];
    bool resc = false;
    WAITB(6, 2);
    {
        kload2(kf, kp0, 0); kload2(kf, kp0, 1); kload2(kf, kp0, 2); kload2(kf, kp0, 3); kload2(kf, kp0, 4); kload2(kf, kp0, 5);
#pragma unroll
        for (int d0 = 0; d0 < 6; ++d0) {
            if (d0 == 0) { pA0 = __builtin_amdgcn_mfma_f32_32x32x16_bf16(kf[0], qr[0], negm, 0, 0, 0); pA1 = __builtin_amdgcn_mfma_f32_32x32x16_bf16(kf[1], qr[0], negm, 0, 0, 0); }
            else { pA0 = __builtin_amdgcn_mfma_f32_32x32x16_bf16(kf[2 * d0], qr[d0], pA0, 0, 0, 0); pA1 = __builtin_amdgcn_mfma_f32_32x32x16_bf16(kf[2 * d0 + 1], qr[d0], pA1, 0, 0, 0); } }
        const float rm = rowmax(pA0, pA1); mhat = rm;
#pragma unroll
        for (int r = 0; r < 16; ++r) { pA0[r] = __builtin_amdgcn_exp2f(pA0[r] - rm); pA1[r] = (r < 8) ? __builtin_amdgcn_exp2f(pA1[r] - rm) : (pA1[r] - rm); }
#pragma unroll
        for (int r = 0; r < 16; ++r) negm[r] = -mhat;
        asm volatile("" : "+v"(negm));
    }
    WAITB(0, 0);
    DMA_K(3, 0); DMA_V(1, 1);
    int sp = 0, sc = 1, sn = 2;
    kload2(kf, kp0 + sc * KSLOT, 0); kload2(kf, kp0 + sc * KSLOT, 1); kload2(kf, kp0 + sc * KSLOT, 2); kload2(kf, kp0 + sc * KSLOT, 3); kload2(kf, kp0 + sc * KSLOT, 4); kload2(kf, kp0 + sc * KSLOT, 5);
    WAITB(3, 2);
#define ROT() do { sp = sc; sc = sn; sn = (sn == NSLOT - 1) ? 0 : sn + 1; } while (0)
#define RESC() do { if (resc) { asm volatile("s_waitcnt lgkmcnt(0)" ::: "memory"); \
        _Pragma("unroll") for (int d_ = 0; d_ < 2; ++d_) _Pragma("unroll") for (int r = 0; r < 16; ++r) o[d_][r] *= wsf[crow(r, hi)]; } } while (0)
    s16x4 vlo[4], vhi[4]; u32x4 pw0, pw1, pw2, pw3;
#define PKW(P, B) cvtpk(P[B], P[B + 1])
#define PAF(k) __builtin_bit_cast(bf16x8, pw##k)
#define VFR(i) (bf16x8){vlo[(i) & 3][0], vlo[(i) & 3][1], vlo[(i) & 3][2], vlo[(i) & 3][3], vhi[(i) & 3][0], vhi[(i) & 3][1], vhi[(i) & 3][2], vhi[(i) & 3][3]}
#define PIN(x) asm volatile("" : "+v"(x))
#define EX(v) __builtin_amdgcn_exp2f(v)
#define VRD(i) do { vlo[(i) & 3] = vtr(vp_ + (((i) >> 2) * 4096 + ((i) & 3) * 1024)); vhi[(i) & 3] = vtr(vp_ + (((i) >> 2) * 4096 + ((i) & 3) * 1024 + 512)); } while (0)
#define KRD(G, j) do { if (G) { kload2(kf, kp0 + sn * KSLOT, j); SBAR(); } } while (0)
#define QK(C, i, d, CIN) C = __builtin_amdgcn_mfma_f32_32x32x16_bf16(kf[i], qr[d], CIN, 0, 0, 0)
#define GAPB(MF, X, B) do { MF; X[B] = EX(X[B]); X[B + 1] = EX(X[B + 1]); X[B + 2] = EX(X[B + 2]); X[B + 3] = EX(X[B + 3]); PIN(X); SBAR(); } while (0)
#define STEP(C0, C1, P0, P1, t, GK, GV, GL) do { SBAR(); \
    const lds_cptr vp_ = vp0 + sp * VSLOT; float sacc; \
    VRD(0); SBAR(); QK(C0, 0, 0, negm);  P1[8] = EX(P1[8]); sacc = P0[0] + P0[1]; sacc += P0[2]; sacc += P0[3]; PIN(sacc); pw0[0] = PKW(P0, 0); PIN(pw0); SBAR(); \
    VRD(1); SBAR(); QK(C1, 1, 0, negm);  P1[9] = EX(P1[9]); sacc += P0[4]; sacc += P0[5]; sacc += P0[6]; PIN(sacc); pw0[1] = PKW(P0, 2); PIN(pw0); SBAR(); \
    VRD(2); SBAR(); QK(C0, 2, 1, C0);    P1[10] = EX(P1[10]); sacc += P0[7]; sacc += P0[8]; sacc += P0[9]; PIN(sacc); pw0[2] = PKW(P0, 4); PIN(pw0); SBAR(); \
    VRD(3); SBAR(); QK(C1, 3, 1, C1);    P1[11] = EX(P1[11]); sacc += P0[10]; sacc += P0[11]; sacc += P0[12]; PIN(sacc); pw0[3] = PKW(P0, 6); PIN(pw0); SBAR(); \
    QK(C0, 4, 2, C0);    P1[12] = EX(P1[12]); sacc += P0[13]; sacc += P0[14]; sacc += P0[15]; PIN(sacc); pw1[0] = PKW(P0, 8); PIN(pw1); SBAR(); \
    QK(C1, 5, 2, C1);    P1[13] = EX(P1[13]); sacc += P1[0]; sacc += P1[1]; sacc += P1[2]; PIN(sacc); pw1[1] = PKW(P0, 10); PIN(pw1); SBAR(); \
    QK(C0, 6, 3, C0);    P1[14] = EX(P1[14]); sacc += P1[3]; sacc += P1[4]; sacc += P1[5]; PIN(sacc); pw1[2] = PKW(P0, 12); PIN(pw1); SBAR(); \
    QK(C1, 7, 3, C1);    P1[15] = EX(P1[15]); sacc += P1[6]; sacc += P1[7]; PIN(sacc); pw1[3] = PKW(P0, 14); PIN(pw1); SBAR(); \
    QK(C0, 8, 4, C0);    sacc += P1[8]; sacc += P1[9]; PIN(sacc); pw2[0] = PKW(P1, 0); pw2[1] = PKW(P1, 2); PIN(pw2); SBAR(); \
    QK(C1, 9, 4, C1);    sacc += P1[10]; sacc += P1[11]; PIN(sacc); pw2[2] = PKW(P1, 4); pw2[3] = PKW(P1, 6); PIN(pw2); SBAR(); \
    QK(C0, 10, 5, C0);   sacc += P1[12]; sacc += P1[13]; PIN(sacc); pw3[0] = PKW(P1, 8); pw3[1] = PKW(P1, 10); PIN(pw3); SBAR(); \
    QK(C1, 11, 5, C1);   sacc += P1[14]; sacc += P1[15]; PIN(sacc); pw3[2] = PKW(P1, 12); pw3[3] = PKW(P1, 14); PIN(pw3); SBAR(); \
    l_reg += sacc; \
    if (GK) { DMA_K((t) + 3, sc); } if (GV) { DMA_V((t) + 1, sn); } \
    { float a = MX3(C0[0], C0[1], C0[2]), b = MX3(C0[3], C0[4], C0[5]), c = MX3(C1[0], C1[1], C1[2]), d = MX3(C1[3], C1[4], C1[5]);   \
      a = MX3(a, C0[6], C0[7]); b = MX3(b, C0[8], C0[9]); c = MX3(c, C1[6], C1[7]); d = MX3(d, C1[8], C1[9]); \
      a = MX3(a, C0[10], C0[11]); b = MX3(b, C0[12], C0[13]); c = MX3(c, C1[10], C1[11]); d = MX3(d, C1[12], C1[13]); \
      a = MX3(a, C0[14], C0[15]); c = MX3(c, C1[14], C1[15]); \
      float rm = MX3(a, b, __builtin_fmaxf(c, d)); { auto rr = __builtin_amdgcn_permlane32_swap(__float_as_uint(rm), __float_as_uint(rm), false, false); rm = __builtin_fmaxf(__uint_as_float(rr[0]), __uint_as_float(rr[1])); } \
      resc = false; \
      if (__builtin_expect(__any(rm > (float)THRL), 0)) { const float dl = __builtin_fmaxf(rm, 0.f); mhat += dl; \
        _Pragma("unroll") for (int r = 0; r < 16; ++r) { C0[r] -= dl; C1[r] -= dl; } \
        _Pragma("unroll") for (int r = 0; r < 16; ++r) negm[r] = -mhat; asm volatile("" : "+v"(negm)); \
        const float f = __builtin_amdgcn_exp2f(-dl); l_reg *= f; if (hi == 0) wsf[r32] = f; resc = true; } } \
    SBAR(); \
    GAPB(o[0] = __builtin_amdgcn_mfma_f32_32x32x16_bf16(PAF(0), VFR(0), o[0], 0, 0, 0), C0, 0); VRD(4); SBAR(); \
    KRD(GL, 0); GAPB(o[0] = __builtin_amdgcn_mfma_f32_32x32x16_bf16(PAF(1), VFR(1), o[0], 0, 0, 0), C0, 4); VRD(5); SBAR(); \
    KRD(GL, 1); GAPB(o[0] = __builtin_amdgcn_mfma_f32_32x32x16_bf16(PAF(2), VFR(2), o[0], 0, 0, 0), C0, 8); VRD(6); SBAR(); \
    KRD(GL, 2); GAPB(o[0] = __builtin_amdgcn_mfma_f32_32x32x16_bf16(PAF(3), VFR(3), o[0], 0, 0, 0), C0, 12); VRD(7); SBAR(); \
    KRD(GL, 3); GAPB(o[1] = __builtin_amdgcn_mfma_f32_32x32x16_bf16(PAF(0), VFR(4), o[1], 0, 0, 0), C1, 0); \
    KRD(GL, 4); GAPB(o[1] = __builtin_amdgcn_mfma_f32_32x32x16_bf16(PAF(1), VFR(5), o[1], 0, 0, 0), C1, 4); \
    KRD(GL, 5); o[1] = __builtin_amdgcn_mfma_f32_32x32x16_bf16(PAF(2), VFR(6), o[1], 0, 0, 0); SBAR(); \
    o[1] = __builtin_amdgcn_mfma_f32_32x32x16_bf16(PAF(3), VFR(7), o[1], 0, 0, 0); SBAR();   \
    } while (0)
    int t = 1;
    for (; t + 4 < NT; t += 2) {
        STEP(pB0, pB1, pA0, pA1, t, true, true, true);       WAITB(3, 2); RESC(); ROT();
        STEP(pA0, pA1, pB0, pB1, t + 1, true, true, true);   WAITB(3, 2); RESC(); ROT();
    }
    STEP(pB0, pB1, pA0, pA1, t, false, true, true);       WAITB(0, 2); RESC(); ROT();
    STEP(pA0, pA1, pB0, pB1, t + 1, false, true, true);   WAITB(0, 0); RESC(); ROT();
    STEP(pB0, pB1, pA0, pA1, NT - 1, false, false, false); RESC();
    {
#pragma unroll
        for (int r = 8; r < 16; ++r) pB1[r] = __builtin_amdgcn_exp2f(pB1[r]);
        float sacc = pB0[0] + pB0[1];
#pragma unroll
        for (int r = 2; r < 16; ++r) sacc += pB0[r];
#pragma unroll
        for (int r = 0; r < 16; ++r) sacc += pB1[r];
        l_reg += sacc;
        pw0 = (u32x4){PKW(pB0, 0), PKW(pB0, 2), PKW(pB0, 4), PKW(pB0, 6)}; pw1 = (u32x4){PKW(pB0, 8), PKW(pB0, 10), PKW(pB0, 12), PKW(pB0, 14)};
        pw2 = (u32x4){PKW(pB1, 0), PKW(pB1, 2), PKW(pB1, 4), PKW(pB1, 6)}; pw3 = (u32x4){PKW(pB1, 8), PKW(pB1, 10), PKW(pB1, 12), PKW(pB1, 14)};
        const lds_cptr vp_ = vp0 + sc * VSLOT;
        VRD(0); VRD(1); VRD(2); VRD(3);
        o[0] = __builtin_amdgcn_mfma_f32_32x32x16_bf16(PAF(0), VFR(0), o[0], 0, 0, 0); o[0] = __builtin_amdgcn_mfma_f32_32x32x16_bf16(PAF(1), VFR(1), o[0], 0, 0, 0);
        o[0] = __builtin_amdgcn_mfma_f32_32x32x16_bf16(PAF(2), VFR(2), o[0], 0, 0, 0); o[0] = __builtin_amdgcn_mfma_f32_32x32x16_bf16(PAF(3), VFR(3), o[0], 0, 0, 0);
        SBAR(); VRD(4); VRD(5); VRD(6); VRD(7);
        o[1] = __builtin_amdgcn_mfma_f32_32x32x16_bf16(PAF(0), VFR(4), o[1], 0, 0, 0); o[1] = __builtin_amdgcn_mfma_f32_32x32x16_bf16(PAF(1), VFR(5), o[1], 0, 0, 0);
        o[1] = __builtin_amdgcn_mfma_f32_32x32x16_bf16(PAF(2), VFR(6), o[1], 0, 0, 0); o[1] = __builtin_amdgcn_mfma_f32_32x32x16_bf16(PAF(3), VFR(7), o[1], 0, 0, 0);
    }
    { auto rr = __builtin_amdgcn_permlane32_swap(__float_as_uint(l_reg), __float_as_uint(l_reg), false, false); l_reg = __uint_as_float(rr[0]) + __uint_as_float(rr[1]); }
    if (hi == 0) wsf[32 + r32] = l_reg;
    asm volatile("s_waitcnt lgkmcnt(0)" ::: "memory");
    float rli[16];
#pragma unroll
    for (int r = 0; r < 16; ++r) rli[r] = __builtin_amdgcn_rcpf(wsf[32 + crow(r, hi)]);
    bf16_t* Ow = Ob + (long)(wid * QBLK) * DM;
    {   LAS bf16_t* stg = (LAS bf16_t*)(shm + LDS_OST) + wid * 2048;
#pragma unroll
        for (int r = 0; r < 16; ++r) { const int orow = crow(r, hi);
#pragma unroll
            for (int d0 = 0; d0 < 2; ++d0) stg[orow * 64 + d0 * 32 + r32] = (bf16_t)(cvtpk(o[d0][r] * rli[r], 0.f) & 0xffffu); }
        asm volatile("s_waitcnt lgkmcnt(0)" ::: "memory");
#pragma unroll
        for (int i = 0; i < 4; ++i) { const int row = i * 8 + (lane >> 3), ch = lane & 7; const u32x4 v = *(const LAS u32x4*)(stg + row * 64 + ch * 8); *(u32x4*)(Ow + (long)row * DM + ch * 8) = v; } }
    asm volatile("s_waitcnt vmcnt(0) lgkmcnt(0)\n\ts_barrier" ::: "memory");
#undef DMA_K
#undef DMA_V
#undef ROT
#undef RESC
#undef PKW
#undef PAF
#undef VFR
#undef PIN
#undef EX
#undef VRD
#undef KRD
#undef QK
#undef GAPB
#undef STEP
}
#undef SBAR
#undef MX3
#undef WAITB
}

namespace na {
constexpr int VP = 144, VBUF = 32 * VP;
constexpr int LDS_RPB = 0, LDS_VB = 16384, LDS_BYTES = LDS_VB + 8 * 2 * VBUF;
typedef short v4i16_t __attribute__((ext_vector_type(4)));
__device__ __forceinline__ void unit(const bf16_t* __restrict__ Z, bf16_t* __restrict__ MIX, const LAS float* rpb, LAS char* vbuf, int tokbase, int rows, int r, int j, int h) {
    const int lane = lane_id_asm();
    const int q = lane & 15, g = lane >> 4;
    const int rs = min(max(r - 4, 0), rows - 8);
    const int bcs = min(max(16 * j - 8, 0), 32);
    const int qtok = tokbase + r * 64 + 16 * j + q;
    const bf16_t* qp = Z + (size_t)qtok * ZP + Z_NQ + h * 64 + 8 * g;
    const bf16x8 qf0 = *(const bf16x8*)qp, qf1 = *(const bf16x8*)(qp + 32);
    const bf16_t* vsrc = Z + (size_t)(tokbase + rs * 64 + bcs) * ZP + Z_NV + h * 64;
    bf16x8 vr[2][4];
#define NA_VLOAD(s) do { _Pragma("unroll") for (int it = 0; it < 4; ++it) { const int id = it * 64 + lane; vr[(s) & 1][it] = *(const bf16x8*)(vsrc + (size_t)((s) * 64 + (id >> 3)) * ZP + (id & 7) * 8); } } while (0)
#define NA_VWRITE(b) do { _Pragma("unroll") for (int it = 0; it < 4; ++it) { const int id = it * 64 + lane; *(LAS bf16x8*)(vbuf + ((b) & 1) * VBUF + (id >> 3) * VP + (id & 7) * 16) = vr[(b) & 1][it]; } } while (0)
    NA_VLOAD(0); NA_VLOAD(1);
    f32x4 acc[16];
    const bf16_t* kbase = Z + (size_t)(tokbase + rs * 64 + bcs + q) * ZP + Z_NK + h * 64 + 8 * g;
#pragma unroll
    for (int t = 0; t < 16; ++t) {
        const bf16_t* kp = kbase + (size_t)((t >> 1) * 64 + 16 * (t & 1)) * ZP;
        const bf16x8 k0 = *(const bf16x8*)kp, k1 = *(const bf16x8*)(kp + 32);
        f32x4 a = {0.f, 0.f, 0.f, 0.f};
        a = __builtin_amdgcn_mfma_f32_16x16x32_bf16(k0, qf0, a, 0, 0, 0);
        a = __builtin_amdgcn_mfma_f32_16x16x32_bf16(k1, qf1, a, 0, 0, 0);
        acc[t] = a;
    }
    const int qcol = 16 * j + q, qs = min(max(qcol - 8, 0), 48);
    float mx = -INFINITY;
#pragma unroll
    for (int t = 0; t < 16; ++t) {
        const int dr = rs + (t >> 1) - r + 7;
#pragma unroll
        for (int i = 0; i < 4; ++i) {
            const int kcol = bcs + 16 * (t & 1) + 4 * g + i;
            const bool valid = (kcol >= qs) && (kcol < qs + 16);
            const int dc = min(max(kcol - qcol + 15, 0), 30);
            float bias = rpb[dr * 31 + dc];
            asm volatile("" : "+v"(bias));
            const float s = valid ? (acc[t][i] * 0.125f + bias) * LOG2E : -INFINITY;
            acc[t][i] = s; mx = fmaxf(mx, s);
        }
    }
    mx = fmaxf(mx, __shfl_xor(mx, 16)); mx = fmaxf(mx, __shfl_xor(mx, 32));
    float l = 0.f;
#pragma unroll
    for (int t = 0; t < 16; ++t)
#pragma unroll
        for (int i = 0; i < 4; ++i) { const float p = __builtin_amdgcn_exp2f(acc[t][i] - mx); acc[t][i] = p; l += p; }
    l += __shfl_xor(l, 16); l += __shfl_xor(l, 32);
    f32x4 o[4];
#pragma unroll
    for (int db = 0; db < 4; ++db) o[db] = (f32x4){0.f, 0.f, 0.f, 0.f};
    const int li = lane & 15;
    LAS char* trb = vbuf + (4 * g + (li >> 2)) * VP + (li & 3) * 8;
    NA_VWRITE(0);
#pragma unroll
    for (int s = 0; s < 8; ++s) {
        if (s + 2 < 8) NA_VLOAD(s + 2);
        u32x4 pw; pw.x = cvtpk(acc[2 * s][0], acc[2 * s][1]); pw.y = cvtpk(acc[2 * s][2], acc[2 * s][3]); pw.z = cvtpk(acc[2 * s + 1][0], acc[2 * s + 1][1]); pw.w = cvtpk(acc[2 * s + 1][2], acc[2 * s + 1][3]);
        const bf16x8 pb = __builtin_bit_cast(bf16x8, pw);
        LAS char* tb = trb + (s & 1) * VBUF;
#pragma unroll
        for (int db = 0; db < 4; ++db) {
            const v4i16_t t0 = __builtin_amdgcn_ds_read_tr16_b64_v4i16((LAS v4i16_t*)(tb + db * 32));
            const v4i16_t t1 = __builtin_amdgcn_ds_read_tr16_b64_v4i16((LAS v4i16_t*)(tb + 16 * VP + db * 32));
            const bf16x8 vf = (bf16x8){t0[0], t0[1], t0[2], t0[3], t1[0], t1[1], t1[2], t1[3]};
            o[db] = __builtin_amdgcn_mfma_f32_16x16x32_bf16(vf, pb, o[db], 0, 0, 0);
        }
        if (s + 1 < 8) NA_VWRITE(s + 1);
    }
    const float rl = __builtin_amdgcn_rcpf(l);
    bf16_t* op = MIX + (size_t)qtok * DM + 512 + h * 64 + 4 * g;
#pragma unroll
    for (int db = 0; db < 4; ++db) { u32x2 w; w.x = cvtpk(o[db][0] * rl, o[db][1] * rl); w.y = cvtpk(o[db][2] * rl, o[db][3] * rl); *(u32x2*)(op + db * 16) = w; }
#undef NA_VLOAD
#undef NA_VWRITE
}

__device__ __forceinline__ float shx(float v, int mask, int lane) { return __builtin_bit_cast(float, __builtin_amdgcn_ds_bpermute((lane ^ mask) << 2, __builtin_bit_cast(int, v))); }
template <int D>
__device__ __forceinline__ void unit2(const bf16_t* __restrict__ Z, bf16_t* __restrict__ MIX, const LAS float* rpb, LAS char* vbuf, int tokbase, int rows, int r0, int j, int h) {
    constexpr int NB = 8 + D;
    const int lane = lane_id_asm();
    const int q = lane & 15, g = lane >> 4;
    const int rs0 = min(max(r0 - 4, 0), rows - 8);
    const int bcs = min(max(16 * j - 8, 0), 32);
    const int qtok = tokbase + r0 * 64 + 16 * j + q;
    bf16x8 qf[2][2];
#pragma unroll
    for (int qr = 0; qr < 2; ++qr) { const bf16_t* qp = Z + (size_t)(qtok + 64 * qr) * ZP + Z_NQ + h * 64 + 8 * g; qf[qr][0] = *(const bf16x8*)qp; qf[qr][1] = *(const bf16x8*)(qp + 32); }
    const bf16_t* vsrc = Z + (size_t)(tokbase + rs0 * 64 + bcs) * ZP + Z_NV + h * 64;
    bf16x8 vr[2][4];
#define NA_VLOAD(s) do { _Pragma("unroll") for (int it = 0; it < 4; ++it) { const int id = it * 64 + lane; vr[(s) & 1][it] = *(const bf16x8*)(vsrc + (size_t)((s) * 64 + (id >> 3)) * ZP + (id & 7) * 8); } } while (0)
#define NA_VWRITE(b) do { _Pragma("unroll") for (int it = 0; it < 4; ++it) { const int id = it * 64 + lane; *(LAS bf16x8*)(vbuf + ((b) & 1) * VBUF + (id >> 3) * VP + (id & 7) * 16) = vr[(b) & 1][it]; } } while (0)
    f32x4 acc[2][16];
    const bf16_t* kbase = Z + (size_t)(tokbase + rs0 * 64 + bcs + q) * ZP + Z_NK + h * 64 + 8 * g;
#pragma unroll
    for (int u = 0; u < NB; ++u)
#pragma unroll
        for (int tp = 0; tp < 2; ++tp) {
            const bf16_t* kp = kbase + (size_t)(u * 64 + 16 * tp) * ZP;
            const bf16x8 k0 = *(const bf16x8*)kp, k1 = *(const bf16x8*)(kp + 32);
            if (u < 8) { f32x4 a = {0.f, 0.f, 0.f, 0.f}; a = __builtin_amdgcn_mfma_f32_16x16x32_bf16(k0, qf[0][0], a, 0, 0, 0); a = __builtin_amdgcn_mfma_f32_16x16x32_bf16(k1, qf[0][1], a, 0, 0, 0); acc[0][2 * u + tp] = a; }
            if (u >= D) { f32x4 a = {0.f, 0.f, 0.f, 0.f}; a = __builtin_amdgcn_mfma_f32_16x16x32_bf16(k0, qf[1][0], a, 0, 0, 0); a = __builtin_amdgcn_mfma_f32_16x16x32_bf16(k1, qf[1][1], a, 0, 0, 0); acc[1][2 * (u >= D ? u - D : 0) + tp] = a; }
        }
    const int qcol = 16 * j + q, qs = min(max(qcol - 8, 0), 48);
    float rl[2];
#pragma unroll
    for (int qr = 0; qr < 2; ++qr) {
        float mx = -INFINITY;
#pragma unroll
        for (int t = 0; t < 16; ++t) {
            const int dr = (rs0 + qr * D) + (t >> 1) - (r0 + qr) + 7;
#pragma unroll
            for (int i = 0; i < 4; ++i) {
                const int kcol = bcs + 16 * (t & 1) + 4 * g + i;
                const bool valid = (kcol >= qs) && (kcol < qs + 16);
                const int dc = min(max(kcol - qcol + 15, 0), 30);
                const float s_all = (acc[qr][t][i] * 0.125f + rpb[dr * 31 + dc]) * LOG2E;
                const float sv = valid ? s_all : -INFINITY;
                acc[qr][t][i] = sv; mx = fmaxf(mx, sv);
            }
        }
        mx = fmaxf(mx, shx(mx, 16, lane)); mx = fmaxf(mx, shx(mx, 32, lane));
        float l = 0.f;
#pragma unroll
        for (int t = 0; t < 16; ++t)
#pragma unroll
            for (int i = 0; i < 4; ++i) { const float p = __builtin_amdgcn_exp2f(acc[qr][t][i] - mx); acc[qr][t][i] = p; l += p; }
        l += shx(l, 16, lane); l += shx(l, 32, lane);
        rl[qr] = __builtin_amdgcn_rcpf(l);
    }
    f32x4 o[2][4];
#pragma unroll
    for (int qr = 0; qr < 2; ++qr)
#pragma unroll
        for (int db = 0; db < 4; ++db) o[qr][db] = (f32x4){0.f, 0.f, 0.f, 0.f};
    NA_VLOAD(0); NA_VLOAD(1);
    const int li = lane & 15;
    LAS char* trb = vbuf + (4 * g + (li >> 2)) * VP + (li & 3) * 8;
    NA_VWRITE(0);
#pragma unroll
    for (int u = 0; u < NB; ++u) {
        if (u + 2 < NB) NA_VLOAD(u + 2);
        LAS char* tb = trb + (u & 1) * VBUF;
        bf16x8 pb0 = {}, pb1 = {};
        if (u < 8) { u32x4 pw; pw.x = cvtpk(acc[0][2 * u][0], acc[0][2 * u][1]); pw.y = cvtpk(acc[0][2 * u][2], acc[0][2 * u][3]); pw.z = cvtpk(acc[0][2 * u + 1][0], acc[0][2 * u + 1][1]); pw.w = cvtpk(acc[0][2 * u + 1][2], acc[0][2 * u + 1][3]);
            pb0 = __builtin_bit_cast(bf16x8, pw); }
        if (u >= D) { const int ir = (u >= D) ? u - D : 0;
            u32x4 pw; pw.x = cvtpk(acc[1][2 * ir][0], acc[1][2 * ir][1]); pw.y = cvtpk(acc[1][2 * ir][2], acc[1][2 * ir][3]); pw.z = cvtpk(acc[1][2 * ir + 1][0], acc[1][2 * ir + 1][1]); pw.w = cvtpk(acc[1][2 * ir + 1][2], acc[1][2 * ir + 1][3]);
            pb1 = __builtin_bit_cast(bf16x8, pw); }
#pragma unroll
        for (int db = 0; db < 4; ++db) {
            const v4i16_t t0 = __builtin_amdgcn_ds_read_tr16_b64_v4i16((LAS v4i16_t*)(tb + db * 32));
            const v4i16_t t1 = __builtin_amdgcn_ds_read_tr16_b64_v4i16((LAS v4i16_t*)(tb + 16 * VP + db * 32));
            const bf16x8 vf = (bf16x8){t0[0], t0[1], t0[2], t0[3], t1[0], t1[1], t1[2], t1[3]};
            if (u < 8) o[0][db] = __builtin_amdgcn_mfma_f32_16x16x32_bf16(vf, pb0, o[0][db], 0, 0, 0);
            if (u >= D) o[1][db] = __builtin_amdgcn_mfma_f32_16x16x32_bf16(vf, pb1, o[1][db], 0, 0, 0);
        }
        if (u + 1 < NB) NA_VWRITE(u + 1);
        __builtin_amdgcn_sched_barrier(0);
    }
#pragma unroll
    for (int qr = 0; qr < 2; ++qr) { bf16_t* op = MIX + (size_t)(qtok + 64 * qr) * DM + 512 + h * 64 + 4 * g;
#pragma unroll
        for (int db = 0; db < 4; ++db) { u32x2 w; w.x = cvtpk(o[qr][db][0] * rl[qr], o[qr][db][1] * rl[qr]); w.y = cvtpk(o[qr][db][2] * rl[qr], o[qr][db][3] * rl[qr]); *(u32x2*)(op + db * 16) = w; } }
#undef NA_VLOAD
#undef NA_VWRITE
}
}

#define XB_TMO      128
#define XB_XCNT(j)  (256  + 64 * (j))
#define XB_XSUB(j)  (1280 + 64 * (j))
#define XB_XGEN(j)  (2304 + 64 * (j))
#define XB_TOP      3328
#define XB_TOPGEN   3392
#define XCD_BAR_WORDS 3456
#define XB_SPIN_CAP (1u << 20)
__device__ __forceinline__ unsigned xb_ld(unsigned* p)              { return __hip_atomic_load(p, __ATOMIC_RELAXED, __HIP_MEMORY_SCOPE_AGENT); }
__device__ __forceinline__ unsigned xb_add(unsigned* p, unsigned v) { return __hip_atomic_fetch_add(p, v, __ATOMIC_RELAXED, __HIP_MEMORY_SCOPE_AGENT); }
__device__ __forceinline__ unsigned xb_xcc_id() { return (unsigned)__builtin_amdgcn_s_getreg((3 << 11) | 20) & 0xFu; }
#define XB_SPIN(cond, bar) do { unsigned _sp = 0; while (cond) { __builtin_amdgcn_s_sleep(1); \
    if ((++_sp & 255u) == 0u) { if (xb_ld(&(bar)[XB_TMO])) break; if (_sp > XB_SPIN_CAP) { atomicAdd(&(bar)[XB_TMO], 1u); break; } } } } while (0)
struct XcdBarrier { unsigned* bar; unsigned x; volatile LAS unsigned* st; };
__device__ __forceinline__ XcdBarrier xcd_barrier_post(unsigned* bar, volatile LAS unsigned* st) {
    XcdBarrier b; b.bar = bar; b.x = xb_xcc_id(); b.st = st;
    if (threadIdx.x == 0) (void)xb_add(&bar[XB_XCNT(b.x)], 1u);
    return b;
}
__device__ __forceinline__ void xcd_barrier_complete(unsigned* bar, unsigned x, unsigned& nloc, unsigned& nx) {
    const unsigned G = gridDim.x * gridDim.y * gridDim.z;
    unsigned sum, cnt, mine, sp = 0u;
    for (;;) {
        sum = 0u; cnt = 0u; mine = 0u;
#pragma unroll
        for (unsigned j = 0; j < 16; ++j) { const unsigned c = xb_ld(&bar[XB_XCNT(j)]); sum += c; cnt += (c > 0u) ? 1u : 0u; mine = (j == x) ? c : mine; }
        if (sum == G) break;
        __builtin_amdgcn_s_sleep(1);
        if ((++sp & 255u) == 0u) { if (xb_ld(&bar[XB_TMO])) break; if (sp > XB_SPIN_CAP) { atomicAdd(&bar[XB_TMO], 1u); break; } }
    }
    nloc = mine > 0u ? mine : 1u; nx = cnt > 0u ? cnt : 1u;
}
__device__ __forceinline__ void xcd_barrier(const XcdBarrier& b) {
    asm volatile("s_waitcnt vmcnt(0)" ::: "memory");
    __syncthreads();
    if (threadIdx.x == 0) {
        unsigned* bar = b.bar;
        __builtin_amdgcn_s_waitcnt(0);
        unsigned nloc = b.st[0], nx = b.st[1];
        if (nloc == 0u) { xcd_barrier_complete(bar, b.x, nloc, nx); b.st[0] = nloc; b.st[1] = nx; }
        const unsigned old = xb_add(&bar[XB_XSUB(b.x)], 1u);
        const unsigned gen = old / nloc;
        if (old + 1u == (gen + 1u) * nloc) {
            __builtin_amdgcn_fence(__ATOMIC_RELEASE, "agent");
            asm volatile("s_waitcnt vmcnt(0)" ::: "memory");
            const unsigned og = xb_add(&bar[XB_TOP], 1u);
            const unsigned tg = og / nx;
            if (og + 1u == (tg + 1u) * nx) xb_add(&bar[XB_TOPGEN], 1u);
            else XB_SPIN(xb_ld(&bar[XB_TOPGEN]) == tg, bar);
            __builtin_amdgcn_fence(__ATOMIC_ACQUIRE, "agent");
            xb_add(&bar[XB_XGEN(b.x)], 1u);
            asm volatile("s_waitcnt vmcnt(0)" ::: "memory");
        } else {
            XB_SPIN(xb_ld(&bar[XB_XGEN(b.x)]) == gen, bar);
            __builtin_amdgcn_fence(__ATOMIC_ACQUIRE, "agent");
            asm volatile("s_waitcnt vmcnt(0)" ::: "memory");
        }
    }
    __syncthreads();
}

struct Params {
    const float* x_prompt; const float* x_sample; const float* g_mix_pre; const float* w_in; const float* g_q_lat; const float* w_q_up;
    const float* g_kv_lat; const float* w_kv_up; const float* na_rpb; const float* w_o; const float* g_mix_post; const float* g_ffn_pre;
    const float* w_ffn_up; const float* ffn_conv_w; const float* ffn_conv_b; const float* w_ffn_down; const float* g_ffn_post;
    float* out; unsigned char* ws;
};
constexpr int LDS_XCH = pg8::STAGE_BYTES + 1024, LDS_TOTAL = LDS_XCH + 8192;

__device__ __forceinline__ const float* xrow(const float* xp, const float* xs, int t) { return t < MP ? xp + (size_t)t * DM : xs + (size_t)(t - MP) * DM; }

__device__ __forceinline__ int srccol(int mode, int n) {
    if (mode == 0) {
        if (n < Z_KR) return n;
        if (n < Z_KR + 32) { const int jj = n - Z_KR; return Z_KR + (jj >> 1) + 16 * (jj & 1); }
        return n < ZP ? n : -1;
    } else if (mode == 1) {
        const int h = n / 96, d = n % 96;
        if (d < 64) return h * 96 + d;
        const int jj = d - 64; return h * 96 + 64 + (jj >> 1) + 16 * (jj & 1);
    } else if (mode == 2) {
        if (n < 512) return (n >> 6) * 128 + (n & 63);
        const int m2 = n - 512; return (m2 >> 6) * 128 + 64 + (m2 & 63);
    }
    if (mode == 4) { const int tile = n >> 8, w = n & 255; return (w < 128) ? (tile * 128 + w) : (DFF + tile * 128 + (w - 128)); }
    return n;
}
__device__ __forceinline__ void transpose_item(const float* __restrict__ W, int K, int Nsrc, bf16_t* __restrict__ WT, int Ndst, const float* __restrict__ kscale, int mode,
                                               LAS float* scr, int it, int lane) {
    const int nblk = Ndst / 32;
    {
        const int kb = it / nblk, nb = it % nblk, k0 = 64 * kb, n0 = 32 * nb;
        const int sc = srccol(mode, n0 + (lane & 31));
        float tv[32];
#pragma unroll
        for (int i = 0; i < 32; ++i) { const int kk = 2 * i + (lane >> 5); tv[i] = (sc >= 0) ? W[(size_t)(k0 + kk) * Nsrc + sc] : 0.f; }
        if (kscale) {
#pragma unroll
            for (int i = 0; i < 32; ++i) tv[i] *= kscale[k0 + 2 * i + (lane >> 5)]; }
#pragma unroll
        for (int i = 0; i < 32; ++i) scr[(2 * i + (lane >> 5)) * 33 + (lane & 31)] = tv[i];
        asm volatile("s_waitcnt lgkmcnt(0)" ::: "memory");
        const int c = lane & 7;
#pragma unroll
        for (int jx = 0; jx < 4; ++jx) { const int n = (lane >> 3) + 8 * jx; const LAS float* s = scr + (8 * c) * 33 + n;
            u32x4 o; o.x = cvtpk(s[0 * 33], s[1 * 33]); o.y = cvtpk(s[2 * 33], s[3 * 33]); o.z = cvtpk(s[4 * 33], s[5 * 33]); o.w = cvtpk(s[6 * 33], s[7 * 33]);
            *(u32x4*)(WT + (size_t)(n0 + n) * K + k0 + 8 * c) = o; }
        asm volatile("s_waitcnt lgkmcnt(0)" ::: "memory");
    }
}

__device__ const double ROPE_INV[16] = {1.0, 0.5623413251903491, 0.31622776601683794, 0.1778279410038923, 0.1, 0.05623413251903491, 0.031622776601683794, 0.01778279410038923,
                                        0.01, 0.005623413251903491, 0.0031622776601683794, 0.001778279410038923, 0.001, 0.0005623413251903491, 0.00031622776601683794, 0.0001778279410038923};


typedef const __attribute__((address_space(4))) Params* CParams;
__device__ __forceinline__ CParams kparams() { CParams q = (CParams)__builtin_amdgcn_kernarg_segment_ptr(); asm volatile("" : "+s"(q)); return q; }
__global__ void __launch_bounds__(512) fwd_kernel(Params p_unused) {
    extern __shared__ __attribute__((aligned(16))) unsigned char lds_raw[];
    LAS unsigned char* lds = (LAS unsigned char*)lds_raw;
    cg::grid_group grid = cg::this_grid();
    const int wave = __builtin_amdgcn_readfirstlane(threadIdx.x >> 6);
#define FRESH_TID() const int lane = lane_id_asm(), tid = wave * 64 + lane; (void)tid
    const int G = gridDim.x, bid = blockIdx.x;
    const int vcu = (G % 8 == 0) ? (bid % 8) * (G / 8) + bid / 8 : bid;
    const int gw = vcu * 8 + wave, NGW = G * 8;
#define PHASE_PTRS() const CParams pp = kparams(); unsigned char* const ws = pp->ws; (void)ws
#define Win_t ((bf16_t*)(ws + WS_WIN))
#define Wq_t ((bf16_t*)(ws + WS_WQ))
#define Wkv_t ((bf16_t*)(ws + WS_WKV))
#define Wo_t ((bf16_t*)(ws + WS_WO))
#define Wup_t ((bf16_t*)(ws + WS_WUP))
#define Wdn_t ((bf16_t*)(ws + WS_WDN))
#define cosT ((float*)(ws + WS_COS))
#define sinT ((float*)(ws + WS_SIN))
#define rstd_q ((float*)(ws + WS_RSQ))
#define rstd_kv ((float*)(ws + WS_RSKV))
#define R1 ((bf16_t*)(ws + WS_R1))
#define Z ((bf16_t*)(ws + WS_Z))
#define Qb ((bf16_t*)(ws + WS_Q))
#define Kb ((bf16_t*)(ws + WS_K))
#define Vb ((bf16_t*)(ws + WS_V))
#define MO ((bf16_t*)(ws + WS_MO))
#define ACT ((bf16_t*)(ws + WS_ACT))

    volatile LAS unsigned* bst = (volatile LAS unsigned*)(lds + pg8::STAGE_BYTES);
    {
        FRESH_TID(); PHASE_PTRS(); const float* xp_ = pp->x_prompt; const float* xs_ = pp->x_sample;
        if (tid < 2) bst[tid] = 0u;
        if (bid == 0) for (int i = tid; i < XCD_BAR_WORDS; i += 512) ((unsigned*)ws)[i] = 0u;
        LAS float* scr = (LAS float*)(lds + wave * 16384);
        {
            constexpr int I0 = 16 * 64, I1 = 4 * 24, I2 = 2 * 32, I3 = 16 * 32, I4 = 16 * 176, I5 = 44 * 32;
            for (int it = gw; it < I0 + I1 + I2 + I3 + I4 + I5; it += NGW) {
                int r = it;
                if (r < I0) { transpose_item(pp->w_in, 1024, 1952, Win_t, 2048, nullptr, 0, scr, r, lane); continue; } r -= I0;
                if (r < I1) { transpose_item(pp->w_q_up, 256, 768, Wq_t, 768, pp->g_q_lat, 1, scr, r, lane); continue; } r -= I1;
                if (r < I2) { transpose_item(pp->w_kv_up, 128, 1024, Wkv_t, 1024, pp->g_kv_lat, 2, scr, r, lane); continue; } r -= I2;
                if (r < I3) { transpose_item(pp->w_o, 1024, 1024, Wo_t, 1024, nullptr, 3, scr, r, lane); continue; } r -= I3;
                if (r < I4) { transpose_item(pp->w_ffn_up, 1024, NUP, Wup_t, NUP, nullptr, 4, scr, r, lane); continue; } r -= I4;
                transpose_item(pp->w_ffn_down, DFF, 1024, Wdn_t, 1024, nullptr, 3, scr, r, lane);
            }
        }
        for (int e = bid * 512 + tid; e < M; e += G * 512) { rstd_q[e] = 0.f; rstd_kv[e] = 0.f; }
        for (int e = bid * 512 + tid; e < SP * 16; e += G * 512) {
            const int s = e >> 4, i = e & 15;
            const double rev = (double)s * ROPE_INV[i] * 0.15915494309189535;
            const float fr = (float)(rev - floor(rev));
            cosT[e] = __builtin_amdgcn_cosf(fr); sinT[e] = __builtin_amdgcn_sinf(fr);
        }
        for (int t = gw; t < M; t += 2 * NGW) {
            f32x4 v[2][4]; float ss[2];
#pragma unroll
            for (int r = 0; r < 2; ++r) { const float* xr = xrow(xp_, xs_, t + r * NGW); ss[r] = 0.f;
#pragma unroll
                for (int j = 0; j < 4; ++j) v[r][j] = *(const f32x4*)(xr + 256 * j + 4 * lane); }
#pragma unroll
            for (int r = 0; r < 2; ++r) {
#pragma unroll
                for (int j = 0; j < 4; ++j) ss[r] += (v[r][j].x * v[r][j].x + v[r][j].y * v[r][j].y) + (v[r][j].z * v[r][j].z + v[r][j].w * v[r][j].w);
                const float rstd = rsqrtf(wave_sum(ss[r]) * (1.f / DM) + EPS);
#pragma unroll
                for (int j = 0; j < 4; ++j) { const f32x4 gg = *(const f32x4*)(pp->g_mix_pre + 256 * j + 4 * lane); const f32x4 o = v[r][j] * rstd * gg;
                    u32x2 w; w.x = cvtpk(o.x, o.y); w.y = cvtpk(o.z, o.w); *(u32x2*)(R1 + (size_t)(t + r * NGW) * DM + 256 * j + 4 * lane) = w; } }
        }
    }
    grid.sync();
    { PHASE_PTRS(); (void)xcd_barrier_post((unsigned*)ws, bst); }
#define GRID_BAR() do { XcdBarrier xb_; xb_.bar = (unsigned*)kparams()->ws; xb_.x = xb_xcc_id(); xb_.st = (volatile LAS unsigned*)(lds + pg8::STAGE_BYTES); xcd_barrier(xb_); } while (0)

    {
        PHASE_PTRS(); pg8::Gemm g{R1, Win_t, M, ZW, 1024, 1024, 1024}; pg8::StaticOrder S; S.init(M, ZW, G, bid);
        pg8::EpiZ E{Z, ZP, rstd_q, rstd_kv, Kb, cosT, sinT};
        pg8::gemm_phase(lds, g, S, E, wave);
    }
    GRID_BAR();
    {
        PHASE_PTRS(); pg8::Gemm g{Z, Wq_t, M, QW, 256, ZP, 256}; pg8::StaticOrder S; S.init(M, QW, G, bid);
        pg8::EpiQ E{Qb, rstd_q, cosT, sinT};
        pg8::gemm_phase(lds, g, S, E, wave);
    }
    {
        PHASE_PTRS(); pg8::Gemm g{Z + Z_CKV, Wkv_t, M, 1024, 128, ZP, 128}; pg8::StaticOrder S; S.init(M, 1024, G, bid);
        pg8::EpiKV E{Kb, Vb, rstd_kv};
        pg8::gemm_phase(lds, g, S, E, wave);
    }
    GRID_BAR();
    {
        FRESH_TID(); PHASE_PTRS();
        for (int it = 0;; ++it) {
            const int slot = it * G + vcu; if (slot >= 1536) break;
            int tokbase, h, qb, seq;
            if (slot < 1024) { const int i = slot >> 8, v = slot & 255, x = v >> 5, c = v & 31; const int pair = 2 * x + (i >> 1); tokbase = (pair >> 3) * SP; h = pair & 7; qb = (i & 1) * 32 + c; seq = SP; }
            else { const int s2 = slot - 1024, i = s2 >> 8, v = s2 & 255, x = v >> 5, c = v & 31; const int u = i * 32 + c, bh = 8 * x + (u >> 3); tokbase = MP + (bh >> 3) * SS; h = bh & 7; qb = u & 7; seq = SS; }
            mla2::attn_unit(Qb + (size_t)(tokbase + qb * 256) * QW + h * 96, Kb + (size_t)(h * NGT + (tokbase >> 6)) * 6144, Vb + (size_t)(h * NGT + (tokbase >> 6)) * 4096,
                           R1 + (size_t)(tokbase + qb * 256) * DM + h * 64, seq, (LAS char*)lds, wave);
        }
        LAS float* rpbl = (LAS float*)(lds + na::LDS_RPB);
        for (int i = tid; i < 8 * 465; i += 512) rpbl[i] = pp->na_rpb[i];
        __syncthreads();
        const int per = (1536 + G - 1) / G;
        LAS char* vbuf = (LAS char*)(lds + na::LDS_VB + wave * 2 * na::VBUF);
        for (int u = vcu * per; u < min(1536, (vcu + 1) * per); ++u) {
            const int grow = (u >> 2) * 2, j = u & 3; int tokbase, rows, r0;
            if (grow < 512) { tokbase = (grow >> 8) * SP; r0 = grow & 255; rows = 256; } else { const int g2 = grow - 512; tokbase = MP + (g2 >> 5) * SS; r0 = g2 & 31; rows = 32; }
            const int rs0 = min(max(r0 - 4, 0), rows - 8), rs1 = min(max(r0 - 3, 0), rows - 8);
            if (rs1 != rs0) na::unit2<1>(Z, R1, rpbl + wave * 465, vbuf, tokbase, rows, r0, j, wave);
            else na::unit2<0>(Z, R1, rpbl + wave * 465, vbuf, tokbase, rows, r0, j, wave);
        }
        __syncthreads();
    }
    GRID_BAR();
    {
        PHASE_PTRS(); pg8::Gemm g{R1, Wo_t, M, 1024, 1024, 1024, 1024}; pg8::StaticOrder S; S.init(M, 1024, G, bid);
        pg8::EpiStore E{MO, MOP};
        pg8::gemm_phase(lds, g, S, E, wave);
    }
    GRID_BAR();
    { FRESH_TID(); PHASE_PTRS(); const float* xp_ = pp->x_prompt; const float* xs_ = pp->x_sample;
    for (int t = gw; t < M; t += 2 * NGW) {
        f32x4 v[2][4], xv[2][4];
#pragma unroll
        for (int r = 0; r < 2; ++r) { const int tr = t + r * NGW; const float* xr = xrow(xp_, xs_, tr);
#pragma unroll
            for (int j = 0; j < 4; ++j) { const u32x2 w = *(const u32x2*)(MO + (size_t)tr * MOP + 256 * j + 4 * lane); v[r][j] = (f32x4){bflo(w.x), bfhi(w.x), bflo(w.y), bfhi(w.y)};
                xv[r][j] = *(const f32x4*)(xr + 256 * j + 4 * lane); } }
#pragma unroll
        for (int r = 0; r < 2; ++r) { const int tr = t + r * NGW; float ss = 0.f;
#pragma unroll
            for (int j = 0; j < 4; ++j) ss += (v[r][j].x * v[r][j].x + v[r][j].y * v[r][j].y) + (v[r][j].z * v[r][j].z + v[r][j].w * v[r][j].w);
            const float rstd = rsqrtf(wave_sum(ss) * (1.f / DM) + EPS);
            float s2 = 0.f;
#pragma unroll
            for (int j = 0; j < 4; ++j) { const f32x4 gg = *(const f32x4*)(pp->g_mix_post + 256 * j + 4 * lane);
                v[r][j] = xv[r][j] + v[r][j] * rstd * gg; s2 += (v[r][j].x * v[r][j].x + v[r][j].y * v[r][j].y) + (v[r][j].z * v[r][j].z + v[r][j].w * v[r][j].w);
                *(f32x4*)(pp->out + (size_t)tr * DM + 256 * j + 4 * lane) = v[r][j]; }
            const float rstd2 = rsqrtf(wave_sum(s2) * (1.f / DM) + EPS);
#pragma unroll
            for (int j = 0; j < 4; ++j) { const f32x4 gg = *(const f32x4*)(pp->g_ffn_pre + 256 * j + 4 * lane); const f32x4 o = v[r][j] * rstd2 * gg;
                u32x2 w; w.x = cvtpk(o.x, o.y); w.y = cvtpk(o.z, o.w); *(u32x2*)(R1 + (size_t)tr * DM + 256 * j + 4 * lane) = w; } }
    } }
    GRID_BAR();
    {
        PHASE_PTRS(); pg8::Gemm g{R1, Wup_t, M, NUP, 1024, 1024, 1024}; pg8::StaticOrder S; S.init_tiles(pg8::OVL_NM, NUP / 256, G, bid);
        pg8::EpiConv E{ACT, pp->ffn_conv_w, pp->ffn_conv_b, (LAS float*)(lds + LDS_XCH)};
        pg8::gemm_phase<pg8::EpiConv, true>(lds, g, S, E, wave);
    }
    GRID_BAR();
    {
        PHASE_PTRS(); pg8::Gemm g{ACT, Wdn_t, M, 1024, DFF, DFF, DFF}; pg8::StaticOrder S; S.init(M, 1024, G, bid);
        pg8::EpiStore E{MO, MOP};
        pg8::gemm_phase(lds, g, S, E, wave);
    }
    GRID_BAR();
    { FRESH_TID(); PHASE_PTRS();
    for (int t = gw; t < M; t += 2 * NGW) {
        f32x4 v[2][4], xv[2][4];
#pragma unroll
        for (int r = 0; r < 2; ++r) { const int tr = t + r * NGW;
#pragma unroll
            for (int j = 0; j < 4; ++j) { const u32x2 w = *(const u32x2*)(MO + (size_t)tr * MOP + 256 * j + 4 * lane); v[r][j] = (f32x4){bflo(w.x), bfhi(w.x), bflo(w.y), bfhi(w.y)};
                xv[r][j] = *(const f32x4*)(pp->out + (size_t)tr * DM + 256 * j + 4 * lane); } }
#pragma unroll
        for (int r = 0; r < 2; ++r) { const int tr = t + r * NGW; float ss = 0.f;
#pragma unroll
            for (int j = 0; j < 4; ++j) ss += (v[r][j].x * v[r][j].x + v[r][j].y * v[r][j].y) + (v[r][j].z * v[r][j].z + v[r][j].w * v[r][j].w);
            const float rstd = rsqrtf(wave_sum(ss) * (1.f / DM) + EPS);
#pragma unroll
            for (int j = 0; j < 4; ++j) { const f32x4 gg = *(const f32x4*)(pp->g_ffn_post + 256 * j + 4 * lane);
                *(f32x4*)(pp->out + (size_t)tr * DM + 256 * j + 4 * lane) = xv[r][j] + v[r][j] * rstd * gg; } }
    } }
}

extern "C" void kernel_launch(void* const* d_in, const int* in_sizes, int n_in, void* d_out, int out_size, void* d_ws, size_t ws_size, hipStream_t stream) {
    static int grid_blocks = 0;
    if (grid_blocks == 0) {
        if (n_in != 17 || in_sizes[0] != MP * DM || in_sizes[1] != MS * DM || out_size != M * DM || ws_size < WS_END) {
            fprintf(stderr, "kernel_launch: unexpected shapes (n_in %d, in0 %d, in1 %d, out %d, ws %zu)\n", n_in, n_in > 0 ? in_sizes[0] : -1, n_in > 1 ? in_sizes[1] : -1, out_size, ws_size);
            grid_blocks = -1; return; }
        int dev = 0, cus = 0, per_cu = 0;
        hipGetDevice(&dev);
        hipDeviceGetAttribute(&cus, hipDeviceAttributeMultiprocessorCount, dev);
        hipFuncSetAttribute((const void*)fwd_kernel, hipFuncAttributeMaxDynamicSharedMemorySize, LDS_TOTAL);
        hipOccupancyMaxActiveBlocksPerMultiprocessor(&per_cu, (const void*)fwd_kernel, 512, LDS_TOTAL);
        if (per_cu < 1) { fprintf(stderr, "kernel_launch: occupancy query returned %d\n", per_cu); per_cu = 1; }
        (void)hipGetLastError();
        grid_blocks = cus * 1;
    }
    if (grid_blocks < 0) return;
    Params p{};
    p.x_prompt = (const float*)d_in[0]; p.x_sample = (const float*)d_in[1]; p.g_mix_pre = (const float*)d_in[2]; p.w_in = (const float*)d_in[3];
    p.g_q_lat = (const float*)d_in[4]; p.w_q_up = (const float*)d_in[5]; p.g_kv_lat = (const float*)d_in[6]; p.w_kv_up = (const float*)d_in[7];
    p.na_rpb = (const float*)d_in[8]; p.w_o = (const float*)d_in[9]; p.g_mix_post = (const float*)d_in[10]; p.g_ffn_pre = (const float*)d_in[11];
    p.w_ffn_up = (const float*)d_in[12]; p.ffn_conv_w = (const float*)d_in[13]; p.ffn_conv_b = (const float*)d_in[14]; p.w_ffn_down = (const float*)d_in[15];
    p.g_ffn_post = (const float*)d_in[16]; p.out = (float*)d_out; p.ws = (unsigned char*)d_ws;
    void* args[] = {&p};
    hipError_t e = hipLaunchCooperativeKernel((const void*)fwd_kernel, dim3(grid_blocks), dim3(512), args, LDS_TOTAL, stream);
    if (e != hipSuccess) fprintf(stderr, "cooperative launch failed: %s (grid %d)\n", hipGetErrorString(e), grid_blocks);
}
```
